# Optimizing an MI355X kernel written in HIP

```python
import jax, jax.numpy as jnp
from jax import lax
import numpy as np

D_MODEL = 1024
BATCH = 16
SEQ = 256
DEPTH = 2
DEC_BATCH = 8
DEC_SEQ = 2048
PAST_LEN = 512

GRID_W = 64
EPS = 1e-6
ROPE_BASE = 10000.0
N_BRANCH = 4
BRANCH_WIDTH = D_MODEL // 4
N_MOD = 9
D_FF = 2816
S5_WIDTH = BRANCH_WIDTH
S5_GROUP = 16
S5_GROUPS = S5_WIDTH // S5_GROUP
S5_STATE = 64
RET_HEADS = 4
RET_DIM = BRANCH_WIDTH // RET_HEADS
RET_WIDTH = RET_HEADS * RET_DIM
RET_CHUNK = 128
CONV_WIDTH = BRANCH_WIDTH
CONV_K = 3
MLA_HEADS = 4
MLA_Q_LORA = 192
MLA_KV_LORA = 128
MLA_NOPE = 64
MLA_ROPE = 32
MLA_V = BRANCH_WIDTH // MLA_HEADS
Q_BLOCK = 128
IN_SIZES = (S5_WIDTH, RET_WIDTH, RET_WIDTH, RET_WIDTH, RET_WIDTH, CONV_WIDTH, CONV_WIDTH, CONV_WIDTH, MLA_Q_LORA, MLA_KV_LORA, MLA_ROPE)
IN_COLS = sum(IN_SIZES)

kernel_name = 'hybrid_diffusion_prefix_trunk_step'


def rmsnorm(x, g):
    xf = x.astype(jnp.float32)
    y = xf * lax.rsqrt(jnp.mean(xf * xf, axis=-1, keepdims=True) + EPS)
    return (y * g.astype(jnp.float32)).astype(x.dtype)


def swiglu(h, w1, w3, w2):
    return jnp.dot(jax.nn.silu(jnp.dot(h, w1)) * jnp.dot(h, w3), w2)


def axial_angles(T, dim):
    rows = T // GRID_W
    row = jnp.repeat(jnp.arange(rows, dtype=jnp.float32), GRID_W)
    col = jnp.tile(jnp.arange(GRID_W, dtype=jnp.float32), rows)
    quarter = dim // 4
    inv = ROPE_BASE ** (-jnp.arange(quarter, dtype=jnp.float32) / quarter)
    ang = jnp.concatenate([row[:, None] * inv, col[:, None] * inv], axis=-1)
    return jnp.cos(ang), jnp.sin(ang)


def apply_rope(x, cos, sin):
    half = x.shape[-1] // 2
    c = cos[None, :, None, :]
    s = sin[None, :, None, :]
    x1 = x[..., :half].astype(jnp.float32)
    x2 = x[..., half:].astype(jnp.float32)
    return jnp.concatenate([x1 * c - x2 * s, x1 * s + x2 * c], axis=-1).astype(x.dtype)


def _complex_affine_combine(e1, e2):
    a1r, a1i, b1r, b1i = e1
    a2r, a2i, b2r, b2i = e2
    ar = a2r * a1r - a2i * a1i
    ai = a2r * a1i + a2i * a1r
    br = a2r * b1r - a2i * b1i + b2r
    bi = a2r * b1i + a2i * b1r + b2i
    return ar, ai, br, bi


def s5_discretize(lam_re, lam_im, log_dt, b_re, b_im):
    lam_re = lam_re.astype(jnp.float32)
    lam_im = lam_im.astype(jnp.float32)
    dt = jnp.exp(log_dt.astype(jnp.float32))[:, None]
    mag = jnp.exp(lam_re * dt)
    ab_re = mag * jnp.cos(lam_im * dt)
    ab_im = mag * jnp.sin(lam_im * dt)
    den = lam_re * lam_re + lam_im * lam_im
    f_re = ((ab_re - 1.0) * lam_re + ab_im * lam_im) / den
    f_im = (ab_im * lam_re - (ab_re - 1.0) * lam_im) / den
    b_re = b_re.astype(jnp.float32)
    b_im = b_im.astype(jnp.float32)
    bb_re = f_re[..., None] * b_re - f_im[..., None] * b_im
    bb_im = f_re[..., None] * b_im + f_im[..., None] * b_re
    return ab_re, ab_im, bb_re, bb_im


def s5_scan_dir(u, lam_re, lam_im, log_dt, b_re, b_im, s0_re, s0_im, reverse):
    ab_re, ab_im, bb_re, bb_im = s5_discretize(lam_re, lam_im, log_dt, b_re, b_im)
    bu_re = jnp.einsum('btgh,gph->btgp', u, bb_re)
    bu_im = jnp.einsum('btgh,gph->btgp', u, bb_im)
    t0 = -1 if reverse else 0
    bu_re = bu_re.at[:, t0].add(ab_re * s0_re - ab_im * s0_im)
    bu_im = bu_im.at[:, t0].add(ab_re * s0_im + ab_im * s0_re)
    a_re = jnp.broadcast_to(ab_re, bu_re.shape)
    a_im = jnp.broadcast_to(ab_im, bu_im.shape)
    _, _, s_re, s_im = lax.associative_scan(_complex_affine_combine, (a_re, a_im, bu_re, bu_im), reverse=reverse, axis=1)
    return s_re, s_im


def s5_mixer(u, s0, lam_re, lam_im, log_dt, b_re, b_im, c_re, c_im, d_skip, w_glu):
    B_, T = u.shape[:2]
    uf = u.astype(jnp.float32).reshape(B_, T, S5_GROUPS, S5_GROUP)
    s0 = s0.astype(jnp.float32)
    tot_re, tot_im, finals = 0.0, 0.0, []
    for d, rev in enumerate((False, True)):
        s_re, s_im = s5_scan_dir(uf, lam_re[d], lam_im[d], log_dt[d], b_re[d], b_im[d], s0[:, d, ..., 0], s0[:, d, ..., 1], rev)
        tot_re = tot_re + s_re
        tot_im = tot_im + s_im
        end = 0 if rev else -1
        finals.append(jnp.stack([s_re[:, end], s_im[:, end]], axis=-1))
    y = jnp.einsum('ghp,btgp->btgh', c_re.astype(jnp.float32), tot_re) - jnp.einsum('ghp,btgp->btgh', c_im.astype(jnp.float32), tot_im)
    y = y.reshape(B_, T, S5_WIDTH) + d_skip.astype(jnp.float32) * uf.reshape(B_, T, S5_WIDTH)
    z = jax.nn.gelu(y)
    out = z * jax.nn.sigmoid(jnp.dot(z, w_glu.astype(jnp.float32)))
    return out.astype(u.dtype), jnp.stack(finals, axis=1)


def retention_dir(q, k, v, log_g, s0, strict):
    B_, T, H, d = q.shape
    n = T // RET_CHUNK

    def chunks(a):
        return a.reshape(B_, n, RET_CHUNK, H, d).transpose(1, 0, 3, 2, 4)

    idx = jnp.arange(RET_CHUNK, dtype=jnp.float32)
    diff = idx[:, None] - idx[None, :]
    mask = (diff > 0) if strict else (diff >= 0)
    dmat = jnp.where(mask, jnp.exp(log_g[:, None, None] * jnp.maximum(diff, 0.0)), 0.0)
    q_dec = jnp.exp(log_g[:, None] * (idx + 1.0))[None, :, :, None]
    k_dec = jnp.exp(log_g[:, None] * (RET_CHUNK - 1.0 - idx))[None, :, :, None]
    c_dec = jnp.exp(log_g * RET_CHUNK)[None, :, None, None]

    def step(s, blk):
        qb, kb, vb = blk
        att = jnp.einsum('bhid,bhjd->bhij', qb, kb) * dmat
        o = jnp.einsum('bhij,bhjd->bhid', att, vb) + jnp.einsum('bhid,bhde->bhie', qb, s) * q_dec
        s = s * c_dec + jnp.einsum('bhjd,bhje->bhde', kb * k_dec, vb)
        return s, o

    s_fin, o = lax.scan(step, s0, (chunks(q), chunks(k), chunks(v)))
    return o.transpose(1, 0, 3, 2, 4).reshape(B_, T, H, d), s_fin


def retention_mixer(rq, rk, rv, rg, s0, decay_logit, gn, rope):
    B_, T = rq.shape[:2]
    shp = (B_, T, RET_HEADS, RET_DIM)
    q = rq.reshape(shp)
    k = rk.reshape(shp)
    if rope is not None:
        q = apply_rope(q, rope[0], rope[1])
        k = apply_rope(k, rope[0], rope[1])
    q = q.astype(jnp.float32)
    k = k.astype(jnp.float32) * (RET_DIM ** -0.5)
    v = rv.reshape(shp).astype(jnp.float32)
    s0 = s0.astype(jnp.float32)
    log_g = jax.nn.log_sigmoid(decay_logit.astype(jnp.float32))
    o_f, s_f = retention_dir(q, k, v, log_g[0], s0[:, 0], False)
    o_b, s_b = retention_dir(jnp.flip(q, 1), jnp.flip(k, 1), jnp.flip(v, 1), log_g[1], s0[:, 1], True)
    o = o_f + jnp.flip(o_b, 1)
    mu = jnp.mean(o, axis=-1, keepdims=True)
    var = jnp.mean(jnp.square(o - mu), axis=-1, keepdims=True)
    o = ((o - mu) * lax.rsqrt(var + EPS)).reshape(B_, T, RET_WIDTH) * gn.astype(jnp.float32)
    out = jax.nn.silu(rg.astype(jnp.float32)) * o
    return out.astype(rg.dtype), jnp.stack([s_f, s_b], axis=1)


def short_conv_mixer(cx, cb, cc, w, b):
    z = cc * cx
    T = z.shape[1]
    pad = CONV_K // 2
    zp = jnp.pad(z, ((0, 0), (pad, pad), (0, 0)))
    y = b
    for j in range(CONV_K):
        y = y + zp[:, j:j + T] * w[j]
    return cb * y


def mla_expand(cache, w_ukv):
    B_, S = cache.shape[:2]
    kv = jnp.dot(cache[..., :MLA_KV_LORA], w_ukv).reshape(B_, S, MLA_HEADS, MLA_NOPE + MLA_V)
    return kv[..., :MLA_NOPE], kv[..., MLA_NOPE:], cache[..., MLA_KV_LORA:]


def mla_attend(q_nope, q_rope, k_nope, k_rope, v):
    B_, T = q_nope.shape[:2]
    n = T // Q_BLOCK
    scale = (MLA_NOPE + MLA_ROPE) ** -0.5

    def block(args):
        qn, qr = args
        s = jnp.einsum('bqhd,bkhd->bhqk', qn, k_nope) + jnp.einsum('bqhd,bkd->bhqk', qr, k_rope)
        p = jax.nn.softmax(s.astype(jnp.float32) * scale, axis=-1).astype(v.dtype)
        return jnp.einsum('bhqk,bkhd->bqhd', p, v)

    qn = q_nope.reshape(B_, n, Q_BLOCK, MLA_HEADS, MLA_NOPE).swapaxes(0, 1)
    qr = q_rope.reshape(B_, n, Q_BLOCK, MLA_HEADS, MLA_ROPE).swapaxes(0, 1)
    o = lax.map(block, (qn, qr))
    return o.swapaxes(0, 1).reshape(B_, T, MLA_HEADS * MLA_V)


def mla_mixer(cq, ckv, kr, q_norm, w_uq, kv_norm, w_ukv, rope, ctx_cache):
    B_, T = cq.shape[:2]
    q = jnp.dot(rmsnorm(cq, q_norm), w_uq).reshape(B_, T, MLA_HEADS, MLA_NOPE + MLA_ROPE)
    q_nope, q_rope = q[..., :MLA_NOPE], q[..., MLA_NOPE:]
    cache = jnp.concatenate([rmsnorm(ckv, kv_norm), kr], axis=-1)
    k_nope, v, k_rope = mla_expand(cache, w_ukv)
    if ctx_cache is not None:
        cos, sin = rope
        q_rope = apply_rope(q_rope, cos, sin)
        k_rope = apply_rope(k_rope[:, :, None, :], cos, sin)[:, :, 0, :]
        kn_c, v_c, kr_c = mla_expand(ctx_cache, w_ukv)
        k_nope = jnp.concatenate([k_nope, kn_c], axis=1)
        v = jnp.concatenate([v, v_c], axis=1)
        k_rope = jnp.concatenate([k_rope, kr_c], axis=1)
    return mla_attend(q_nope, q_rope, k_nope, k_rope, v), cache


def parallel_mixers(h, p, ctx):
    B_, T, _ = h.shape
    splits = np.cumsum(IN_SIZES)[:-1].tolist()
    u, rq, rk, rv, rg, cx, cb, cc, cq, ckv, kr = jnp.split(jnp.dot(h, p['w_in']), splits, axis=-1)
    if ctx is None:
        s5_0 = jnp.zeros((B_, 2, S5_GROUPS, S5_STATE, 2), jnp.float32)
        ret_0 = jnp.zeros((B_, 2, RET_HEADS, RET_DIM, RET_DIM), jnp.float32)
        mla_ctx, rope_ret, rope_mla = None, None, None
    else:
        s5_0, ret_0, mla_ctx = ctx
        rope_ret = axial_angles(T, RET_DIM)
        rope_mla = axial_angles(T, MLA_ROPE)
    y_s5, s5_fin = s5_mixer(u, s5_0, p['s5_lam_re'], p['s5_lam_im'], p['s5_log_dt'], p['s5_b_re'], p['s5_b_im'], p['s5_c_re'], p['s5_c_im'], p['s5_d'], p['s5_w_glu'])
    y_ret, ret_fin = retention_mixer(rq, rk, rv, rg, ret_0, p['ret_decay'], p['ret_gn'], rope_ret)
    y_conv = short_conv_mixer(cx, cb, cc, p['conv_w'], p['conv_b'])
    y_mla, mla_cache = mla_mixer(cq, ckv, kr, p['mla_q_norm'], p['mla_w_uq'], p['mla_kv_norm'], p['mla_w_ukv'], rope_mla, mla_ctx)
    branches = jnp.stack([y_s5, y_ret, y_conv.astype(h.dtype), y_mla.astype(h.dtype)], axis=2)
    proj = jnp.einsum('btnw,nwd->btnd', branches, p['w_branch'])
    gates = jax.nn.sigmoid(jnp.dot(h, p['w_gate']) + p['b_gate']).reshape(B_, T, N_BRANCH, D_MODEL)
    merged = jnp.einsum('btnd,btnd->btd', gates, proj)
    return jnp.dot(merged, p['w_o']), (s5_fin, ret_fin, mla_cache)


def trunk_layer(x, cond, p, ctx):
    B_ = x.shape[0]
    mod = (jnp.dot(jax.nn.silu(cond), p['w_mod']) + p['b_mod']).reshape(B_, N_MOD, 1, D_MODEL)
    sh1, sc1, g1, sh2, sc2, g2, sh3, sc3, g3 = [mod[:, i] for i in range(N_MOD)]
    h = rmsnorm(x, p['norm_pre'][0]) * (1.0 + sc1) + sh1
    f = swiglu(h, p['ffn_w1'][0], p['ffn_w3'][0], p['ffn_w2'][0])
    x = x + 0.5 * g1 * rmsnorm(f, p['norm_post'][0])
    h = rmsnorm(x, p['norm_pre'][1]) * (1.0 + sc2) + sh2
    m, state = parallel_mixers(h, p, ctx)
    x = x + g2 * rmsnorm(m, p['norm_post'][1])
    h = rmsnorm(x, p['norm_pre'][2]) * (1.0 + sc3) + sh3
    f = swiglu(h, p['ffn_w1'][1], p['ffn_w3'][1], p['ffn_w2'][1])
    x = x + 0.5 * g3 * rmsnorm(f, p['norm_post'][2])
    return x, state


def setup_inputs(seed: int = 0) -> dict:
    key = jax.random.key(seed)
    ks = iter(jax.random.split(key, 48))
    f32 = jnp.float32

    def nrm(shape, scale):
        return scale * jax.random.normal(next(ks), shape, f32)

    def gain(shape):
        return 1.0 + nrm(shape, 0.02)

    lam_im0 = jnp.pi * jnp.arange(S5_STATE, dtype=f32)
    ret_logit0 = jnp.log(2.0 ** (5.0 + jnp.arange(RET_HEADS, dtype=f32)) - 1.0)
    return {
        'x_prompt': nrm((BATCH, SEQ, D_MODEL), 1.0),
        'x_sample': nrm((DEC_BATCH, DEC_SEQ, D_MODEL), 1.0),
        'state_s5': nrm((DEC_BATCH, DEPTH, 2, S5_GROUPS, S5_STATE, 2), 0.5),
        'state_ret': nrm((DEC_BATCH, DEPTH, 2, RET_HEADS, RET_DIM, RET_DIM), 0.1),
        'cache_mla': nrm((DEC_BATCH, DEPTH, PAST_LEN, MLA_KV_LORA + MLA_ROPE), 1.0),
        'c': nrm((DEC_BATCH, D_MODEL), 1.0),
        'c_ctx': nrm((D_MODEL,), 1.0),
        'w_mod': nrm((DEPTH, D_MODEL, N_MOD * D_MODEL), 0.5 * D_MODEL ** -0.5),
        'b_mod': nrm((DEPTH, N_MOD * D_MODEL), 0.01),
        'norm_pre': gain((DEPTH, 3, D_MODEL)),
        'norm_post': gain((DEPTH, 3, D_MODEL)),
        'ffn_w1': nrm((DEPTH, 2, D_MODEL, D_FF), D_MODEL ** -0.5),
        'ffn_w3': nrm((DEPTH, 2, D_MODEL, D_FF), D_MODEL ** -0.5),
        'ffn_w2': nrm((DEPTH, 2, D_FF, D_MODEL), D_FF ** -0.5),
        'w_in': nrm((DEPTH, D_MODEL, IN_COLS), D_MODEL ** -0.5),
        's5_lam_re': -0.5 + nrm((DEPTH, 2, S5_GROUPS, S5_STATE), 0.01),
        's5_lam_im': lam_im0 + nrm((DEPTH, 2, S5_GROUPS, S5_STATE), 0.01),
        's5_log_dt': jax.random.uniform(next(ks), (DEPTH, 2, S5_GROUPS), f32, float(np.log(1e-3)), float(np.log(1e-1))),
        's5_b_re': nrm((DEPTH, 2, S5_GROUPS, S5_STATE, S5_GROUP), (2.0 * S5_GROUP) ** -0.5),
        's5_b_im': nrm((DEPTH, 2, S5_GROUPS, S5_STATE, S5_GROUP), (2.0 * S5_GROUP) ** -0.5),
        's5_c_re': nrm((DEPTH, S5_GROUPS, S5_GROUP, S5_STATE), (2.0 * S5_STATE) ** -0.5),
        's5_c_im': nrm((DEPTH, S5_GROUPS, S5_GROUP, S5_STATE), (2.0 * S5_STATE) ** -0.5),
        's5_d': nrm((DEPTH, S5_WIDTH), 1.0),
        's5_w_glu': nrm((DEPTH, S5_WIDTH, S5_WIDTH), S5_WIDTH ** -0.5),
        'ret_decay': ret_logit0 + nrm((DEPTH, 2, RET_HEADS), 0.1),
        'ret_gn': gain((DEPTH, RET_WIDTH)),
        'conv_w': nrm((DEPTH, CONV_K, CONV_WIDTH), CONV_K ** -0.5),
        'conv_b': nrm((DEPTH, CONV_WIDTH), 0.01),
        'mla_q_norm': gain((DEPTH, MLA_Q_LORA)),
        'mla_w_uq': nrm((DEPTH, MLA_Q_LORA, MLA_HEADS * (MLA_NOPE + MLA_ROPE)), MLA_Q_LORA ** -0.5),
        'mla_kv_norm': gain((DEPTH, MLA_KV_LORA)),
        'mla_w_ukv': nrm((DEPTH, MLA_KV_LORA, MLA_HEADS * (MLA_NOPE + MLA_V)), MLA_KV_LORA ** -0.5),
        'w_branch': nrm((DEPTH, N_BRANCH, BRANCH_WIDTH, D_MODEL), BRANCH_WIDTH ** -0.5),
        'w_gate': nrm((DEPTH, D_MODEL, N_BRANCH * D_MODEL), D_MODEL ** -0.5),
        'b_gate': nrm((DEPTH, N_BRANCH * D_MODEL), 0.01),
        'w_o': nrm((DEPTH, D_MODEL, D_MODEL), D_MODEL ** -0.5),
    }


def reference(x_prompt, x_sample, state_s5, state_ret, cache_mla, c, c_ctx, w_mod, b_mod, norm_pre, norm_post, ffn_w1, ffn_w3, ffn_w2, w_in, s5_lam_re, s5_lam_im, s5_log_dt, s5_b_re, s5_b_im, s5_c_re, s5_c_im, s5_d, s5_w_glu, ret_decay, ret_gn, conv_w, conv_b, mla_q_norm, mla_w_uq, mla_kv_norm, mla_w_ukv, w_branch, w_gate, b_gate, w_o):
    y_prompt = x_prompt
    y_sample = x_sample
    cond_ctx = jnp.broadcast_to(c_ctx, (x_prompt.shape[0], D_MODEL))
    s5_list, ret_list, mla_list = [], [], []
    for l in range(DEPTH):
        p = dict(w_mod=w_mod[l], b_mod=b_mod[l], norm_pre=norm_pre[l], norm_post=norm_post[l],
                 ffn_w1=ffn_w1[l], ffn_w3=ffn_w3[l], ffn_w2=ffn_w2[l], w_in=w_in[l],
                 s5_lam_re=s5_lam_re[l], s5_lam_im=s5_lam_im[l], s5_log_dt=s5_log_dt[l],
                 s5_b_re=s5_b_re[l], s5_b_im=s5_b_im[l], s5_c_re=s5_c_re[l], s5_c_im=s5_c_im[l],
                 s5_d=s5_d[l], s5_w_glu=s5_w_glu[l], ret_decay=ret_decay[l], ret_gn=ret_gn[l],
                 conv_w=conv_w[l], conv_b=conv_b[l], mla_q_norm=mla_q_norm[l], mla_w_uq=mla_w_uq[l],
                 mla_kv_norm=mla_kv_norm[l], mla_w_ukv=mla_w_ukv[l], w_branch=w_branch[l],
                 w_gate=w_gate[l], b_gate=b_gate[l], w_o=w_o[l])
        y_prompt, (s5_s, ret_s, mla_c) = trunk_layer(y_prompt, cond_ctx, p, None)
        s5_list.append(s5_s)
        ret_list.append(ret_s)
        mla_list.append(mla_c)
        y_sample, _ = trunk_layer(y_sample, c, p, (state_s5[:, l], state_ret[:, l], cache_mla[:, l]))
    new_state_s5 = jnp.stack(s5_list, axis=1)
    new_state_ret = jnp.stack(ret_list, axis=1)
    new_cache_mla = jnp.stack(mla_list, axis=1)
    return (y_prompt, y_sample, new_state_s5, new_state_ret, new_cache_mla)
```

```cpp
#include <hip/hip_runtime.h>
#include <cstdio>
#include <cstdint>

#define LAS __attribute__((address_space(3)))
typedef unsigned short bf16_t;
typedef short bf16x8 __attribute__((ext_vector_type(8)));
typedef float f32x4 __attribute__((ext_vector_type(4)));
typedef unsigned u32x4 __attribute__((ext_vector_type(4)));
typedef unsigned u32x2 __attribute__((ext_vector_type(2)));

constexpr int D = 1024, NTOK = 20480, NPT = 4096, FF = 2816, NWAVES = 8, NTHR = 512;
constexpr int PLD = 2176;
constexpr float EPS = 1e-6f;
constexpr int PC_U = 0, PC_RQ = 256, PC_RK = 512, PC_RG = 768, PC_CX = 1024, PC_CB = 1280, PC_CC = 1536, PC_CQ = 1792, PC_CKV = 1984, PC_KR = 2112;
constexpr float QSCALE = 0.10206207261596577f * 1.4426950408889634f;

constexpr size_t MiB = 1u << 20;
constexpr size_t WS_CTL = 0, CTL_BYTES = 1 * MiB;
constexpr size_t WS_MOD = 1 * MiB;
constexpr size_t WS_ROPE = 2 * MiB;
constexpr size_t WS_CTXA = 3 * MiB;
constexpr size_t WS_S5PW = 5 * MiB;
constexpr size_t WS_S5BB = WS_S5PW + 1081344;
constexpr size_t WS_S5K = WS_S5BB + 524288;
constexpr size_t WS_W = 9 * MiB;
constexpr size_t WS_H = 77 * MiB;
constexpr size_t WS_BR = 117 * MiB;
constexpr size_t WS_G = 157 * MiB;
constexpr size_t WS_END = 357 * MiB;
static_assert(WS_S5K + 2097152 <= WS_W, "misc");
constexpr size_t WO_13A = 0, WO_2A = WO_13A + 5632 * 1024, WO_13B = WO_2A + 1024 * 2816, WO_2B = WO_13B + 5632 * 1024,
                 WO_IN = WO_2B + 1024 * 2816, WO_G = WO_IN + 2560 * 1024, WO_BR = WO_G + 4096 * 1024, WO_O = WO_BR + 4 * 1024 * 256,
                 WO_UQ = WO_O + 1024 * 1024, WO_UK = WO_UQ + 384 * 192, WO_UV = WO_UK + 256 * 128, WO_UKC = WO_UV + 256 * 128, WO_UVC = WO_UKC + 256 * 128,
                 WO_GLU = WO_UVC + 256 * 128, WO_S5T = WO_GLU + 256 * 256, WO_S5WS = WO_S5T + 16 * 512 * 512, WO_S5WO = WO_S5WS + 16 * 256 * 512,
                 WO_END = WO_S5WO + 16 * 512 * 256;
static_assert(WO_END * 2 <= 68 * MiB, "weights region");
constexpr size_t GO_PROJ = 0;
constexpr size_t GO_QB = GO_PROJ + (size_t)NTOK * PLD * 2;
constexpr size_t GO_KB = GO_QB + (size_t)NTOK * 384 * 2;
constexpr size_t GO_VT = GO_KB + (size_t)24576 * 384 * 2;
constexpr size_t GO_RKT = GO_VT + (size_t)24576 * 256 * 2;
constexpr size_t GO_RVT = GO_RKT + (size_t)NTOK * 256 * 2;
constexpr size_t GO_RETKV = GO_RVT + (size_t)NTOK * 256 * 2;
constexpr size_t GO_RETSIN = GO_RETKV + (size_t)160 * 8 * 4096 * 4;
constexpr size_t GO_S5LOC = GO_RETSIN + (size_t)160 * 8 * 4096 * 2;
constexpr size_t GO_S5SIN = GO_S5LOC + (size_t)640 * 16 * 256 * 4;
constexpr size_t GO_END = GO_S5SIN + (size_t)640 * 16 * 256 * 2;
static_assert(GO_END <= 200 * MiB, "G region");
static_assert((size_t)NTOK * 4096 * 2 <= 200 * MiB, "gates");
constexpr int CW_BAR = 4096;

constexpr size_t OUT_S5 = 20971520, OUT_RET = OUT_S5 + 131072, OUT_CACHE = OUT_RET + 1048576;

struct Params { const float* in[36]; float* out; unsigned char* ws; };
__device__ __forceinline__ unsigned long long karg_q(int byte_off) {
    auto ka = __builtin_amdgcn_kernarg_segment_ptr();
    unsigned long long v; asm volatile("s_load_dwordx2 %0, %1, %2\n\ts_waitcnt lgkmcnt(0)" : "=s"(v) : "s"(ka), "s"(byte_off)); return v; }
__device__ __forceinline__ const float* ain(int k) { return (const float*)karg_q(8 * k); }
__device__ __forceinline__ float* aout() { return (float*)karg_q(288); }
__device__ __forceinline__ unsigned char* aws() { return (unsigned char*)karg_q(296); }

__device__ __forceinline__ float bflo(unsigned u) { return __uint_as_float(u << 16); }
__device__ __forceinline__ float bfhi(unsigned u) { return __uint_as_float(u & 0xffff0000u); }
__device__ __forceinline__ float bf1(bf16_t v) { return __uint_as_float(((unsigned)v) << 16); }
__device__ __forceinline__ unsigned f2bf(float f) { unsigned u = __float_as_uint(f); return (u + 0x7fffu + ((u >> 16) & 1u)) >> 16; }
__device__ __forceinline__ unsigned pk2(float lo, float hi) { return f2bf(lo) | (f2bf(hi) << 16); }
__device__ __forceinline__ u32x2 pk4(f32x4 v) { u32x2 r; r.x = pk2(v[0], v[1]); r.y = pk2(v[2], v[3]); return r; }
__device__ __forceinline__ f32x4 up4(u32x2 u) { f32x4 r; r[0] = bflo(u.x); r[1] = bfhi(u.x); r[2] = bflo(u.y); r[3] = bfhi(u.y); return r; }
__device__ __forceinline__ float sigm(float x) { return 1.f / (1.f + __expf(-x)); }
__device__ __forceinline__ float silu(float x) { return x / (1.f + __expf(-x)); }
__device__ __forceinline__ float gelu_t(float x) { const float a = 1.5957691216057308f * (x + 0.044715f * x * x * x); return x / (1.f + __expf(-a)); }
__device__ __forceinline__ float wave_sum(float v) {
#pragma unroll
    for (int o = 1; o < 64; o <<= 1) v += __shfl_xor(v, o);
    return v;
}
__device__ __forceinline__ int tok_seq(int tok) { return tok < NPT ? (tok >> 8) : 16 + ((tok - NPT) >> 11); }
__device__ __forceinline__ int tok_t(int tok) { return tok < NPT ? (tok & 255) : ((tok - NPT) & 2047); }
__device__ __forceinline__ int tok_cond(int tok) { return tok < NPT ? 0 : 1 + ((tok - NPT) >> 11); }
__device__ __forceinline__ int tok_keyrow(int tok) { return tok < NPT ? tok : NPT + ((tok - NPT) >> 11) * 2560 + ((tok - NPT) & 2047); }
__device__ __forceinline__ int seq_len(int s) { return s < 16 ? 256 : 2048; }
__device__ __forceinline__ int seq_start(int s) { return s < 16 ? s * 256 : NPT + (s - 16) * 2048; }
__device__ __forceinline__ int seq_keys(int s) { return s < 16 ? 256 : 2560; }
__device__ __forceinline__ int seq_kbase(int s) { return s < 16 ? s * 256 : NPT + (s - 16) * 2560; }

#define XB_TMO      128
#define XB_XCNT(j)  (256  + 64 * (j))
#define XB_XSUB(j)  (1280 + 64 * (j))
#define XB_XGEN(j)  (2304 + 64 * (j))
#define XB_TOP      3328
#define XB_TOPGEN   3392
#define XCD_BAR_WORDS 3456
#define XB_SPIN_CAP (1u << 22)
__device__ __forceinline__ unsigned xb_ld(unsigned* p)              { return __hip_atomic_load(p, __ATOMIC_RELAXED, __HIP_MEMORY_SCOPE_AGENT); }
__device__ __forceinline__ unsigned xb_add(unsigned* p, unsigned v) { return __hip_atomic_fetch_add(p, v, __ATOMIC_RELAXED, __HIP_MEMORY_SCOPE_AGENT); }
__device__ __forceinline__ unsigned xb_xcc_id() { return (unsigned)__builtin_amdgcn_s_getreg((3 << 11) | 20) & 0xFu; }
#define XB_SPIN(cond, bar) do { unsigned _sp = 0; while (cond) { __builtin_amdgcn_s_sleep(1); \
    if ((++_sp & 255u) == 0u) { if (xb_ld(&(bar)[XB_TMO])) break; if (_sp > XB_SPIN_CAP) { atomicAdd(&(bar)[XB_TMO], 1u); break; } } } } while (0)
struct XcdBarrier { unsigned* bar; unsigned x; volatile LAS unsigned* st; };
__device__ __forceinline__ XcdBarrier xcd_barrier_post(unsigned* bar, volatile LAS unsigned* st) {
    XcdBarrier b; b.bar = bar; b.x = xb_xcc_id(); b.st = st;
    if (threadIdx.x == 0) (void)xb_add(&bar[XB_XCNT(b.x)], 1u);
    return b;
}
__device__ __forceinline__ void xcd_barrier_complete(unsigned* bar, unsigned x, unsigned& nloc, unsigned& nx) {
    const unsigned G = gridDim.x * gridDim.y * gridDim.z;
    unsigned sum, cnt, mine, sp = 0u;
    for (;;) {
        sum = 0u; cnt = 0u; mine = 0u;
#pragma unroll
        for (unsigned j = 0; j < 16; ++j) { const unsigned c = xb_ld(&bar[XB_XCNT(j)]); sum += c; cnt += (c > 0u) ? 1u : 0u; mine = (j == x) ? c : mine; }
        if (sum == G) break;
        __builtin_amdgcn_s_sleep(1);
        if ((++sp & 255u) == 0u) { if (xb_ld(&bar[XB_TMO])) break; if (sp > XB_SPIN_CAP) { atomicAdd(&bar[XB_TMO], 1u); break; } }
    }
    nloc = mine > 0u ? mine : 1u; nx = cnt > 0u ? cnt : 1u;
}
__device__ __forceinline__ void xcd_barrier(const XcdBarrier& b) {
    asm volatile("s_waitcnt vmcnt(0)" ::: "memory");
    __syncthreads();
    if (threadIdx.x == 0) {
        unsigned* bar = b.bar;
        __builtin_amdgcn_s_waitcnt(0);
        unsigned nloc = b.st[0], nx = b.st[1];
        if (nloc == 0u) { xcd_barrier_complete(bar, b.x, nloc, nx); b.st[0] = nloc; b.st[1] = nx; }
        const unsigned old = xb_add(&bar[XB_XSUB(b.x)], 1u);
        const unsigned gen = old / nloc;
        if (old + 1u == (gen + 1u) * nloc) {
            __builtin_amdgcn_fence(__ATOMIC_RELEASE, "agent");
            asm volatile("s_waitcnt vmcnt(0)" ::: "memory");
            const unsigned og = xb_add(&bar[XB_TOP], 1u);
            const unsigned tg = og / nx;
            if (og + 1u == (tg + 1u) * nx) xb_add(&bar[XB_TOPGEN], 1u);
            else XB_SPIN(xb_ld(&bar[XB_TOPGEN]) == tg, bar);
            __builtin_amdgcn_fence(__ATOMIC_ACQUIRE, "agent");
            xb_add(&bar[XB_XGEN(b.x)], 1u);
            asm volatile("s_waitcnt vmcnt(0)" ::: "memory");
        } else {
            XB_SPIN(xb_ld(&bar[XB_XGEN(b.x)]) == gen, bar);
            __builtin_amdgcn_fence(__ATOMIC_ACQUIRE, "agent");
            asm volatile("s_waitcnt vmcnt(0)" ::: "memory");
        }
    }
    __syncthreads();
}

constexpr int G_ROWB = 144, G_ABUF = 128 * G_ROWB, G_LDS = 4 * G_ABUF;
template <bool ROWSSQ, class AF>
__device__ __forceinline__ void gemm_main(LAS unsigned char* lds, f32x4 (&acc)[2][4], float (&ssq)[2], AF aptr, const bf16_t* __restrict__ Bt, int ldb, int K, int m0, int n0, bool swap) {
    const int tid = threadIdx.x, lane = tid & 63, wave = tid >> 6, wm = wave >> 1, wn = wave & 1, lr = lane & 15, g = lane >> 4;
    const int nk = K >> 6;
    u32x4 ra[2], rb[2];
    const int lrow0 = tid >> 3, lkc = tid & 7;
    auto gload = [&](int kt) {
#pragma unroll
        for (int i = 0; i < 2; ++i) {
            const int row = lrow0 + 64 * i;
            ra[i] = *(const u32x4*)aptr(m0 + row, kt * 8 + lkc);
            rb[i] = *(const u32x4*)(Bt + (size_t)(n0 + row) * ldb + kt * 64 + lkc * 8);
        }
    };
    auto sstore = [&](int buf) {
#pragma unroll
        for (int i = 0; i < 2; ++i) {
            const int row = lrow0 + 64 * i;
            *(LAS u32x4*)(lds + buf * G_ABUF + row * G_ROWB + lkc * 16) = ra[i];
            *(LAS u32x4*)(lds + (2 + buf) * G_ABUF + row * G_ROWB + lkc * 16) = rb[i];
        }
    };
    gload(0); sstore(0); __syncthreads();
    for (int kt = 0; kt < nk; ++kt) {
        const int buf = kt & 1;
        if (kt + 1 < nk) gload(kt + 1);
#pragma unroll
        for (int ks = 0; ks < 2; ++ks) {
            bf16x8 af[2], bfr[4];
#pragma unroll
            for (int mt = 0; mt < 2; ++mt) af[mt] = *(const LAS bf16x8*)(lds + buf * G_ABUF + (32 * wm + 16 * mt + lr) * G_ROWB + (4 * ks + g) * 16);
#pragma unroll
            for (int nt = 0; nt < 4; ++nt) bfr[nt] = *(const LAS bf16x8*)(lds + (2 + buf) * G_ABUF + (64 * wn + 16 * nt + lr) * G_ROWB + (4 * ks + g) * 16);
            if (ROWSSQ) {
#pragma unroll
                for (int mt = 0; mt < 2; ++mt)
#pragma unroll
                    for (int j = 0; j < 8; ++j) { const float v = bf1((bf16_t)af[mt][j]); ssq[mt] += v * v; }
            }
            if (swap) {
#pragma unroll
                for (int mt = 0; mt < 2; ++mt)
#pragma unroll
                    for (int nt = 0; nt < 4; ++nt) acc[mt][nt] = __builtin_amdgcn_mfma_f32_16x16x32_bf16(af[mt], bfr[nt], acc[mt][nt], 0, 0, 0);
            } else {
#pragma unroll
                for (int mt = 0; mt < 2; ++mt)
#pragma unroll
                    for (int nt = 0; nt < 4; ++nt) acc[mt][nt] = __builtin_amdgcn_mfma_f32_16x16x32_bf16(bfr[nt], af[mt], acc[mt][nt], 0, 0, 0);
            }
        }
        if (kt + 1 < nk) sstore(buf ^ 1);
        __syncthreads();
    }
}
__device__ __forceinline__ void acc_zero(f32x4 (&acc)[2][4]) {
#pragma unroll
    for (int a = 0; a < 2; ++a)
#pragma unroll
        for (int b = 0; b < 4; ++b) acc[a][b] = (f32x4){0.f, 0.f, 0.f, 0.f};
}
__device__ __forceinline__ void ssq_finish(float (&ssq)[2]) {
#pragma unroll
    for (int mt = 0; mt < 2; ++mt) { ssq[mt] += __shfl_xor(ssq[mt], 16); ssq[mt] += __shfl_xor(ssq[mt], 32); }
}
struct APlain { const bf16_t* A; int lda; __device__ __forceinline__ const bf16_t* operator()(int row, int kc) const { return A + (size_t)row * lda + kc * 8; } };
struct AS5U { const bf16_t* proj; int g; __device__ __forceinline__ const bf16_t* operator()(int row, int kc) const { return proj + (size_t)(row * 32 + (kc >> 1)) * PLD + PC_U + 16 * g + 8 * (kc & 1); } };

struct Frame {
    LAS unsigned char* lds;
    int tid, lane, wave, bid, G;
    int gw, NGW, gt, NGT;
};
extern __shared__ __attribute__((aligned(16))) unsigned char lds_raw[];
__device__ __forceinline__ Frame mkframe() {
    Frame F; int tid = threadIdx.x, bid = blockIdx.x, G = gridDim.x;
    asm volatile("" : "+v"(tid)); asm volatile("" : "+s"(bid), "+s"(G));
    F.lds = (LAS unsigned char*)lds_raw;
    F.tid = tid; F.lane = tid & 63; F.wave = __builtin_amdgcn_readfirstlane(tid >> 6); F.bid = bid; F.G = G;
    F.gw = F.bid * NWAVES + F.wave; F.NGW = F.G * NWAVES; F.gt = F.bid * NTHR + F.tid; F.NGT = F.G * NTHR;
    return F;
}

__device__ __forceinline__ void ph_mod() {
    const Frame F = mkframe(); unsigned char* const WS = aws(); float* const OUTP = aout(); (void)WS; (void)OUTP;
    LAS float* sc = (LAS float*)F.lds;
    LAS float* part = (LAS float*)(F.lds + 36864);
    float* mod = (float*)(WS + WS_MOD);
    bool loaded = false;
    for (int it = F.bid; it < 288; it += F.G) {
        if (!loaded) {
            for (int i = F.tid; i < 9 * 1024; i += NTHR) { const int r = i >> 10, k = i & 1023; const float c = r == 0 ? ain(6)[k] : ain(5)[(r - 1) * 1024 + k]; sc[i] = silu(c); }
            loaded = true;
        }
        __syncthreads();
        const int l = it / 144, n0 = (it % 144) * 64;
        const float* W = ain(7) + (size_t)l * 1024 * 9216 + n0 + F.lane;
        float a[9];
#pragma unroll
        for (int r = 0; r < 9; ++r) a[r] = 0.f;
        const int k0 = F.wave * 128;
#pragma unroll 8
        for (int k = 0; k < 128; ++k) {
            const float w = W[(size_t)(k0 + k) * 9216];
#pragma unroll
            for (int r = 0; r < 9; ++r) a[r] += sc[r * 1024 + k0 + k] * w;
        }
#pragma unroll
        for (int r = 0; r < 9; ++r) part[(F.wave * 9 + r) * 64 + F.lane] = a[r];
        __syncthreads();
        for (int i = F.tid; i < 576; i += NTHR) {
            const int r = i >> 6, c = i & 63; float s = 0.f;
#pragma unroll
            for (int w = 0; w < 8; ++w) s += part[(w * 9 + r) * 64 + c];
            mod[((size_t)l * 9 + r) * 9216 + n0 + c] = s + ain(8)[(size_t)l * 9216 + n0 + c];
        }
    }
    __syncthreads();
}

__device__ __forceinline__ void ph_tables() {
    const Frame F = mkframe(); unsigned char* const WS = aws(); float* const OUTP = aout(); (void)WS; (void)OUTP;
    float* rr = (float*)(WS + WS_ROPE);
    for (int i = F.gt; i < 2048 * 32; i += F.NGT) {
        const int t = i >> 5, k = i & 31; const float pos = (float)(k < 16 ? (t >> 6) : (t & 63));
        const float inv = powf(10000.0f, -(float)(k & 15) / 16.0f); const float ang = pos * inv;
        rr[i] = cosf(ang); rr[65536 + i] = sinf(ang);
    }
    for (int i = F.gt; i < 2048 * 16; i += F.NGT) {
        const int t = i >> 4, k = i & 15; const float pos = (float)(k < 8 ? (t >> 6) : (t & 63));
        const float inv = powf(10000.0f, -(float)(k & 7) / 8.0f); const float ang = pos * inv;
        rr[131072 + i] = cosf(ang); rr[131072 + 32768 + i] = sinf(ang);
    }
    bf16_t* ca = (bf16_t*)(WS + WS_CTXA);
    for (int i = F.gt; i < 2 * 4096 * 32; i += F.NGT) {
        const int c4 = i & 31, row = (i >> 5) & 4095, l = i >> 17, b = row >> 9, j = row & 511;
        const f32x4 v = *(const f32x4*)(ain(4) + ((size_t)(b * 2 + l) * 512 + j) * 160 + c4 * 4);
        *(u32x2*)(ca + ((size_t)l * 4096 + row) * 128 + c4 * 4) = pk4(v);
    }
    float* pw = (float*)(WS + WS_S5PW); float* bb = (float*)(WS + WS_S5BB);
    for (int ch = F.gt; ch < 4096; ch += F.NGT) {
        const int ldg = ch >> 6;
        const float lre = ain(15)[ch], lim = ain(16)[ch], dt = expf(ain(17)[ldg]);
        float abr = 0.f, abi = 0.f;
        for (int e = 0; e <= 32; ++e) {
            const float mag = expf(lre * dt * (float)e), ang = lim * dt * (float)e;
            const float cr = mag * cosf(ang), ci = mag * sinf(ang);
            pw[((size_t)ch * 33 + e) * 2] = cr; pw[((size_t)ch * 33 + e) * 2 + 1] = ci;
            if (e == 1) { abr = cr; abi = ci; }
        }
        const float den = lre * lre + lim * lim;
        const float fre = ((abr - 1.0f) * lre + abi * lim) / den, fim = (abi * lre - (abr - 1.0f) * lim) / den;
        for (int h = 0; h < 16; ++h) {
            const float br = ain(18)[(size_t)ch * 16 + h], bi = ain(19)[(size_t)ch * 16 + h];
            bb[((size_t)ch * 16 + h) * 2] = fre * br - fim * bi; bb[((size_t)ch * 16 + h) * 2 + 1] = fre * bi + fim * br;
        }
    }
}

__device__ __forceinline__ void ph_s5k() {
    const Frame F = mkframe(); unsigned char* const WS = aws(); float* const OUTP = aout(); (void)WS; (void)OUTP;
    const float* pw = (const float*)(WS + WS_S5PW); const float* bb = (const float*)(WS + WS_S5BB); float* Kd = (float*)(WS + WS_S5K);
    for (int i = F.gt; i < 2 * 2 * 16 * 32 * 256; i += F.NGT) {
        const int hp = i & 15, h = (i >> 4) & 15, dl = (i >> 8) & 31, g = (i >> 13) & 15, d = (i >> 17) & 1, l = i >> 18;
        const float* cr = ain(20) + ((size_t)(l * 16 + g) * 16 + h) * 64; const float* ci = ain(21) + ((size_t)(l * 16 + g) * 16 + h) * 64;
        const size_t ch0 = ((size_t)(l * 2 + d) * 16 + g) * 64;
        float s = 0.f;
        for (int q = 0; q < 64; ++q) {
            const float pr = pw[((ch0 + q) * 33 + dl) * 2], pi = pw[((ch0 + q) * 33 + dl) * 2 + 1];
            const float br = bb[((ch0 + q) * 16 + hp) * 2], bi = bb[((ch0 + q) * 16 + hp) * 2 + 1];
            const float wr = pr * br - pi * bi, wi = pr * bi + pi * br;
            s += cr[q] * wr - ci[q] * wi;
        }
        Kd[i] = s;
    }
}

__device__ __forceinline__ void ph_s5mat(int l) {
    const Frame F = mkframe(); unsigned char* const WS = aws(); float* const OUTP = aout(); (void)WS; (void)OUTP;
    const float* pw = (const float*)(WS + WS_S5PW); const float* bb = (const float*)(WS + WS_S5BB); const float* Kd = (const float*)(WS + WS_S5K);
    bf16_t* Wb = (bf16_t*)(WS + WS_W);
    for (int i = F.gt; i < 16 * 512 * 64; i += F.NGT) {
        const int k8 = i & 63, n = (i >> 6) & 511, g = i >> 15, t = n >> 4, h = n & 15, tau = k8 >> 1, h0 = (k8 & 1) * 8;
        float v[8];
#pragma unroll
        for (int j = 0; j < 8; ++j) v[j] = 0.f;
        if (t >= tau) { const float* s = Kd + ((((size_t)(l * 2 + 0) * 16 + g) * 32 + (t - tau)) * 16 + h) * 16 + h0;
#pragma unroll
            for (int j = 0; j < 8; ++j) v[j] += s[j]; }
        if (tau >= t) { const float* s = Kd + ((((size_t)(l * 2 + 1) * 16 + g) * 32 + (tau - t)) * 16 + h) * 16 + h0;
#pragma unroll
            for (int j = 0; j < 8; ++j) v[j] += s[j]; }
        if (t == tau) { const float dsk = ain(22)[l * 256 + 16 * g + h];
#pragma unroll
            for (int j = 0; j < 8; ++j) if (h0 + j == h) v[j] += dsk; }
        u32x4 o; o.x = pk2(v[0], v[1]); o.y = pk2(v[2], v[3]); o.z = pk2(v[4], v[5]); o.w = pk2(v[6], v[7]);
        *(u32x4*)(Wb + WO_S5T + ((size_t)g * 512 + n) * 512 + k8 * 8) = o;
    }
    for (int i = F.gt; i < 16 * 256 * 64; i += F.NGT) {
        const int k8 = i & 63, n = (i >> 6) & 255, g = i >> 14, d = n >> 7, ri = (n >> 6) & 1, q = n & 63, tau = k8 >> 1, h0 = (k8 & 1) * 8;
        const size_t ch = ((size_t)(l * 2 + d) * 16 + g) * 64 + q; const int e = d == 0 ? 31 - tau : tau;
        const float pr = pw[(ch * 33 + e) * 2], pi = pw[(ch * 33 + e) * 2 + 1];
        float v[8];
#pragma unroll
        for (int j = 0; j < 8; ++j) { const float br = bb[(ch * 16 + h0 + j) * 2], bi = bb[(ch * 16 + h0 + j) * 2 + 1]; v[j] = ri == 0 ? pr * br - pi * bi : pr * bi + pi * br; }
        u32x4 o; o.x = pk2(v[0], v[1]); o.y = pk2(v[2], v[3]); o.z = pk2(v[4], v[5]); o.w = pk2(v[6], v[7]);
        *(u32x4*)(Wb + WO_S5WS + ((size_t)g * 256 + n) * 512 + k8 * 8) = o;
    }
    for (int i = F.gt; i < 16 * 512 * 32; i += F.NGT) {
        const int k8 = i & 31, n = (i >> 5) & 511, g = i >> 14, t = n >> 4, h = n & 15, d = k8 >> 4, ri = (k8 >> 3) & 1, q0 = (k8 & 7) * 8;
        const int e = d == 0 ? t + 1 : 32 - t;
        const float* cr = ain(20) + ((size_t)(l * 16 + g) * 16 + h) * 64 + q0; const float* ci = ain(21) + ((size_t)(l * 16 + g) * 16 + h) * 64 + q0;
        float v[8];
#pragma unroll
        for (int j = 0; j < 8; ++j) { const size_t ch = ((size_t)(l * 2 + d) * 16 + g) * 64 + q0 + j; const float pr = pw[(ch * 33 + e) * 2], pi = pw[(ch * 33 + e) * 2 + 1];
            v[j] = ri == 0 ? cr[j] * pr - ci[j] * pi : -(cr[j] * pi + ci[j] * pr); }
        u32x4 o; o.x = pk2(v[0], v[1]); o.y = pk2(v[2], v[3]); o.z = pk2(v[4], v[5]); o.w = pk2(v[6], v[7]);
        *(u32x4*)(Wb + WO_S5WO + ((size_t)g * 512 + n) * 256 + k8 * 8) = o;
    }
}

template <class DF>
__device__ __forceinline__ void tr_item(const float* __restrict__ W, int K, int N, bf16_t* WT, int ldk, const float* kscale, DF dest, LAS float* scr, int item, int lane) {
    const int nblk = N >> 5, kb = item / nblk, nb = item - kb * nblk, k0 = 64 * kb, n0 = 32 * nb;
#pragma unroll 8
    for (int i = 0; i < 32; ++i) { const int kk = 2 * i + (lane >> 5); float v = W[(size_t)(k0 + kk) * N + n0 + (lane & 31)]; if (kscale) v *= kscale[k0 + kk]; scr[kk * 33 + (lane & 31)] = v; }
    asm volatile("s_waitcnt lgkmcnt(0)" ::: "memory");
    const int c = lane & 7;
#pragma unroll
    for (int j = 0; j < 4; ++j) { const int n = (lane >> 3) + 8 * j; const LAS float* s = scr + (8 * c) * 33 + n;
        u32x4 o; o.x = pk2(s[0 * 33], s[1 * 33]); o.y = pk2(s[2 * 33], s[3 * 33]); o.z = pk2(s[4 * 33], s[5 * 33]); o.w = pk2(s[6 * 33], s[7 * 33]);
        *(u32x4*)(WT + (size_t)dest(n0 + n) * ldk + k0 + 8 * c) = o; }
    asm volatile("s_waitcnt lgkmcnt(0)" ::: "memory");
}
__device__ __forceinline__ void ph_wprep(int l) {
    const Frame F = mkframe(); unsigned char* const WS = aws(); float* const OUTP = aout(); (void)WS; (void)OUTP;
    LAS float* scr = (LAS float*)(F.lds + F.wave * 8448);
    bf16_t* Wb = (bf16_t*)(WS + WS_W);
    auto ident = [](int n) { return n; };
    auto dw1 = [](int j) { return 64 * (j >> 5) + (j & 31); };
    auto dw3 = [](int j) { return 64 * (j >> 5) + 32 + (j & 31); };
    auto dkv = [](int c) { const int h = c >> 7, w = c & 127; return (w < 64 ? 0 : 256) + h * 64 + (w & 63); };
    constexpr int I_UP = 16 * 88, I_DN = 44 * 32, I_IN = 16 * 75, I_G = 16 * 128, I_BR = 4 * 32, I_O = 16 * 32, I_UQ = 3 * 12, I_KV = 2 * 16, I_GLU = 4 * 8;
    constexpr int NIT = 4 * I_UP + 2 * I_DN + I_IN + I_G + 4 * I_BR + I_O + I_UQ + 2 * I_KV + I_GLU;
    for (int it = F.gw; it < NIT; it += F.NGW) {
        int r = it;
        if (r < 4 * I_UP) { const int which = r / I_UP, f = which >> 1, w3 = which & 1; r -= which * I_UP;
            const float* W = ain(w3 ? 12 : 11) + (size_t)(l * 2 + f) * 1024 * FF; bf16_t* O = Wb + (f ? WO_13B : WO_13A);
            if (w3) tr_item(W, 1024, FF, O, 1024, nullptr, dw3, scr, r, F.lane); else tr_item(W, 1024, FF, O, 1024, nullptr, dw1, scr, r, F.lane);
            continue; }
        r -= 4 * I_UP;
        if (r < 2 * I_DN) { const int f = r / I_DN; r -= f * I_DN; tr_item(ain(13) + (size_t)(l * 2 + f) * FF * 1024, FF, 1024, Wb + (f ? WO_2B : WO_2A), FF, nullptr, ident, scr, r, F.lane); continue; }
        r -= 2 * I_DN;
        if (r < I_IN) { tr_item(ain(14) + (size_t)l * 1024 * 2400, 1024, 2400, Wb + WO_IN, 1024, nullptr, ident, scr, r, F.lane); continue; }
        r -= I_IN;
        if (r < I_G) { tr_item(ain(33) + (size_t)l * 1024 * 4096, 1024, 4096, Wb + WO_G, 1024, nullptr, ident, scr, r, F.lane); continue; }
        r -= I_G;
        if (r < 4 * I_BR) { const int n = r / I_BR; r -= n * I_BR; tr_item(ain(32) + (size_t)(l * 4 + n) * 256 * 1024, 256, 1024, Wb + WO_BR + (size_t)n * 1024 * 256, 256, nullptr, ident, scr, r, F.lane); continue; }
        r -= 4 * I_BR;
        if (r < I_O) { tr_item(ain(35) + (size_t)l * 1024 * 1024, 1024, 1024, Wb + WO_O, 1024, nullptr, ident, scr, r, F.lane); continue; }
        r -= I_O;
        if (r < I_UQ) { tr_item(ain(29) + (size_t)l * 192 * 384, 192, 384, Wb + WO_UQ, 192, ain(28) + l * 192, ident, scr, r, F.lane); continue; }
        r -= I_UQ;
        if (r < I_KV) { tr_item(ain(31) + (size_t)l * 128 * 512, 128, 512, Wb + WO_UK, 128, ain(30) + l * 128, dkv, scr, r, F.lane); continue; }
        r -= I_KV;
        if (r < I_KV) { tr_item(ain(31) + (size_t)l * 128 * 512, 128, 512, Wb + WO_UKC, 128, nullptr, dkv, scr, r, F.lane); continue; }
        r -= I_KV;
        tr_item(ain(23) + (size_t)l * 256 * 256, 256, 256, Wb + WO_GLU, 256, nullptr, ident, scr, r, F.lane);
    }
}

template <bool FIRST, bool HAS_F, bool HAS_H>
__device__ __forceinline__ void ph_rowpass(const bf16_t* fbuf, const float* npost, const float* modl_g, int gi, float gs,
                                           const float* npre, const float* modl_h, int shi, int sci) {
    const Frame F = mkframe(); unsigned char* const WS = aws(); float* const OUTP = aout(); (void)WS; (void)OUTP;
    bf16_t* Hb = (bf16_t*)(WS + WS_H);
    for (int row = F.gw; row < NTOK; row += F.NGW) {
        const int r = tok_cond(row);
        const float* xr = FIRST ? (row < NPT ? ain(0) + (size_t)row * D : ain(1) + (size_t)(row - NPT) * D) : OUTP + (size_t)row * D;
        f32x4 x[4];
#pragma unroll
        for (int j = 0; j < 4; ++j) x[j] = *(const f32x4*)(xr + 4 * F.lane + 256 * j);
        if (HAS_F) {
            f32x4 fv[4]; float s = 0.f;
#pragma unroll
            for (int j = 0; j < 4; ++j) { fv[j] = up4(*(const u32x2*)(fbuf + (size_t)row * D + 4 * F.lane + 256 * j)); s += fv[j][0] * fv[j][0] + fv[j][1] * fv[j][1] + fv[j][2] * fv[j][2] + fv[j][3] * fv[j][3]; }
            const float rstd = rsqrtf(wave_sum(s) * (1.0f / D) + EPS);
#pragma unroll
            for (int j = 0; j < 4; ++j) {
                const f32x4 np = *(const f32x4*)(npost + 4 * F.lane + 256 * j);
                const f32x4 gg = *(const f32x4*)(modl_g + (size_t)r * 9216 + gi * 1024 + 4 * F.lane + 256 * j);
                x[j] = x[j] + gs * gg * (fv[j] * rstd * np);
                *(f32x4*)(OUTP + (size_t)row * D + 4 * F.lane + 256 * j) = x[j];
            }
        }
        if (HAS_H) {
            float s = 0.f;
#pragma unroll
            for (int j = 0; j < 4; ++j) s += x[j][0] * x[j][0] + x[j][1] * x[j][1] + x[j][2] * x[j][2] + x[j][3] * x[j][3];
            const float rstd = rsqrtf(wave_sum(s) * (1.0f / D) + EPS);
#pragma unroll
            for (int j = 0; j < 4; ++j) {
                const f32x4 np = *(const f32x4*)(npre + 4 * F.lane + 256 * j);
                const f32x4 sc = *(const f32x4*)(modl_h + (size_t)r * 9216 + sci * 1024 + 4 * F.lane + 256 * j);
                const f32x4 sh = *(const f32x4*)(modl_h + (size_t)r * 9216 + shi * 1024 + 4 * F.lane + 256 * j);
                const f32x4 h = (x[j] * rstd * np) * (1.0f + sc) + sh;
                *(u32x2*)(Hb + (size_t)row * D + 4 * F.lane + 256 * j) = pk4(h);
            }
        }
    }
}

__device__ __forceinline__ void ph_ffn_up(int f) {
    const Frame F = mkframe(); unsigned char* const WS = aws(); float* const OUTP = aout(); (void)WS; (void)OUTP;
    const bf16_t* Hb = (const bf16_t*)(WS + WS_H); const bf16_t* Bt = (const bf16_t*)(WS + WS_W) + (f ? WO_13B : WO_13A);
    bf16_t* hid = (bf16_t*)(WS + WS_G);
    const int lr = F.lane & 15, g = F.lane >> 4, wm = F.wave >> 1, wn = F.wave & 1;
    for (int it = F.bid; it < 160 * 44; it += F.G) {
        const int mtile = it / 44, ntile = it - mtile * 44, m0 = mtile * 128, n0 = ntile * 128;
        f32x4 acc[2][4]; float ssq[2] = {0.f, 0.f}; acc_zero(acc);
        gemm_main<false>(F.lds, acc, ssq, APlain{Hb, D}, Bt, D, D, m0, n0, false);
        const int grp = (n0 + 64 * wn) >> 6;
#pragma unroll
        for (int mt = 0; mt < 2; ++mt) { const int row = m0 + 32 * wm + 16 * mt + lr;
#pragma unroll
            for (int nt = 0; nt < 2; ++nt) { f32x4 v;
#pragma unroll
                for (int r = 0; r < 4; ++r) v[r] = silu(acc[mt][nt][r]) * acc[mt][nt + 2][r];
                *(u32x2*)(hid + (size_t)row * FF + 32 * grp + 16 * nt + 4 * g) = pk4(v); } }
    }
}
__device__ __forceinline__ void ph_gemm_n1024(const bf16_t* A, int K, const bf16_t* Bt, bf16_t* O) {
    const Frame F = mkframe(); unsigned char* const WS = aws(); float* const OUTP = aout(); (void)WS; (void)OUTP;
    const int lr = F.lane & 15, g = F.lane >> 4, wm = F.wave >> 1, wn = F.wave & 1;
    for (int it = F.bid; it < 160 * 8; it += F.G) {
        const int mtile = it >> 3, ntile = it & 7, m0 = mtile * 128, n0 = ntile * 128;
        f32x4 acc[2][4]; float ssq[2] = {0.f, 0.f}; acc_zero(acc);
        gemm_main<false>(F.lds, acc, ssq, APlain{A, K}, Bt, K, K, m0, n0, false);
#pragma unroll
        for (int mt = 0; mt < 2; ++mt) { const int row = m0 + 32 * wm + 16 * mt + lr;
#pragma unroll
            for (int nt = 0; nt < 4; ++nt) *(u32x2*)(O + (size_t)row * D + n0 + 64 * wn + 16 * nt + 4 * g) = pk4(acc[mt][nt]); }
    }
}
__device__ __forceinline__ void ph_win() {
    const Frame F = mkframe(); unsigned char* const WS = aws(); float* const OUTP = aout(); (void)WS; (void)OUTP;
    const bf16_t* Hb = (const bf16_t*)(WS + WS_H); const bf16_t* Bt = (const bf16_t*)(WS + WS_W) + WO_IN;
    bf16_t* proj = (bf16_t*)(WS + WS_G + GO_PROJ); bf16_t* rkT = (bf16_t*)(WS + WS_G + GO_RKT); bf16_t* rvT = (bf16_t*)(WS + WS_G + GO_RVT);
    const float* rRc = (const float*)(WS + WS_ROPE); const float* rRs = rRc + 65536; const float* rMc = rRc + 131072; const float* rMs = rMc + 32768;
    const int lr = F.lane & 15, g = F.lane >> 4, wm = F.wave >> 1, wn = F.wave & 1;
    for (int it = F.bid; it < 160 * 20; it += F.G) {
        const int mtile = it / 20, ntile = it - mtile * 20, m0 = mtile * 128, n0 = ntile * 128;
        const bool swap = (n0 >= 512 && n0 < 1024);
        f32x4 acc[2][4]; float ssq[2] = {0.f, 0.f}; acc_zero(acc);
        gemm_main<false>(F.lds, acc, ssq, APlain{Hb, D}, Bt, D, D, m0, n0, swap);
        const int cb = n0 + 64 * wn; const bool samp = m0 >= NPT;
        if (!swap) {
#pragma unroll
            for (int mt = 0; mt < 2; ++mt) {
                const int tok = m0 + 32 * wm + 16 * mt + lr, t = tok_t(tok);
                if (samp && cb >= 256 && cb < 512) {
#pragma unroll
                    for (int nt = 0; nt < 2; ++nt) { const f32x4 c = *(const f32x4*)(rRc + t * 32 + 16 * nt + 4 * g), s = *(const f32x4*)(rRs + t * 32 + 16 * nt + 4 * g);
                        const f32x4 x1 = acc[mt][nt], x2 = acc[mt][nt + 2]; acc[mt][nt] = x1 * c - x2 * s; acc[mt][nt + 2] = x1 * s + x2 * c; }
                }
                if (samp && cb == 2368) {
                    const f32x4 c = *(const f32x4*)(rMc + t * 16 + 4 * g), s = *(const f32x4*)(rMs + t * 16 + 4 * g);
                    const f32x4 x1 = acc[mt][0], x2 = acc[mt][1]; acc[mt][0] = x1 * c - x2 * s; acc[mt][1] = x1 * s + x2 * c;
                }
#pragma unroll
                for (int nt = 0; nt < 4; ++nt) { const int pc = cb + 16 * nt + 4 * g; if (pc >= 2400) continue;
                    const int oc = pc < 768 ? pc : pc - 256; *(u32x2*)(proj + (size_t)tok * PLD + oc) = pk4(acc[mt][nt]); }
            }
        } else if (cb < 768) {
            const int head = (cb - 512) >> 6;
#pragma unroll
            for (int mt = 0; mt < 2; ++mt) {
                const int tok0 = m0 + 32 * wm + 16 * mt + 4 * g, t0 = tok_t(tok0);
                if (samp) {
#pragma unroll
                    for (int nt = 0; nt < 2; ++nt)
#pragma unroll
                        for (int r = 0; r < 4; ++r) { const float c = rRc[(t0 + r) * 32 + 16 * nt + lr], s = rRs[(t0 + r) * 32 + 16 * nt + lr];
                            const float x1 = acc[mt][nt][r], x2 = acc[mt][nt + 2][r]; acc[mt][nt][r] = x1 * c - x2 * s; acc[mt][nt + 2][r] = x1 * s + x2 * c; }
                }
#pragma unroll
                for (int nt = 0; nt < 4; ++nt) { const int dk = 16 * nt + lr; const f32x4 v = acc[mt][nt] * 0.125f;
#pragma unroll
                    for (int r = 0; r < 4; ++r) proj[(size_t)(tok0 + r) * PLD + PC_RK + head * 64 + dk] = (bf16_t)f2bf(v[r]);
                    *(u32x2*)(rkT + (((size_t)(tok0 >> 7) * 4 + head) * 64 + dk) * 128 + (tok0 & 127)) = pk4(v); }
            }
        } else {
            const int head = (cb - 768) >> 6;
#pragma unroll
            for (int mt = 0; mt < 2; ++mt) { const int tok0 = m0 + 32 * wm + 16 * mt + 4 * g;
#pragma unroll
                for (int nt = 0; nt < 4; ++nt) { const int dv = 16 * nt + lr;
                    *(u32x2*)(rvT + (((size_t)(tok0 >> 7) * 4 + head) * 64 + dv) * 128 + (tok0 & 127)) = pk4(acc[mt][nt]); } }
        }
    }
}
__device__ __forceinline__ void ph_gate(int l) {
    const Frame F = mkframe(); unsigned char* const WS = aws(); float* const OUTP = aout(); (void)WS; (void)OUTP;
    const bf16_t* Hb = (const bf16_t*)(WS + WS_H); const bf16_t* Wb = (const bf16_t*)(WS + WS_W);
    bf16_t* gates = (bf16_t*)(WS + WS_G); bf16_t* br = (bf16_t*)(WS + WS_BR);
    const bf16_t* zb = (const bf16_t*)(WS + WS_G + GO_S5LOC);
    const int lr = F.lane & 15, g = F.lane >> 4, wm = F.wave >> 1, wn = F.wave & 1;
    for (int it = F.bid; it < 160 * 2; it += F.G) {
        const int mtile = it >> 1, ntile = it & 1, m0 = mtile * 128, n0 = ntile * 128;
        f32x4 acc[2][4]; float ssq[2] = {0.f, 0.f}; acc_zero(acc);
        gemm_main<false>(F.lds, acc, ssq, APlain{zb, 256}, Wb + WO_GLU, 256, 256, m0, n0, false);
#pragma unroll
        for (int mt = 0; mt < 2; ++mt) { const int row = m0 + 32 * wm + 16 * mt + lr;
#pragma unroll
            for (int nt = 0; nt < 4; ++nt) { const int col = n0 + 64 * wn + 16 * nt + 4 * g; const f32x4 z = up4(*(const u32x2*)(zb + (size_t)row * 256 + col)); f32x4 o;
#pragma unroll
                for (int r = 0; r < 4; ++r) o[r] = z[r] * sigm(acc[mt][nt][r]);
                *(u32x2*)(br + (size_t)row * D + col) = pk4(o); } }
    }
    (void)l; (void)gates; (void)Hb;
}
__device__ __forceinline__ void ph_gate2(int l) {
    const Frame F = mkframe(); unsigned char* const WS = aws(); float* const OUTP = aout(); (void)WS; (void)OUTP;
    const bf16_t* Hb = (const bf16_t*)(WS + WS_H); const bf16_t* Wb = (const bf16_t*)(WS + WS_W);
    bf16_t* gates = (bf16_t*)(WS + WS_G);
    const float* bg = ain(34) + (size_t)l * 4096;
    const int lr = F.lane & 15, g = F.lane >> 4, wm = F.wave >> 1, wn = F.wave & 1;
    for (int it = F.bid; it < 160 * 32; it += F.G) {
        const int mtile = it >> 5, ntile = it & 31, m0 = mtile * 128, n0 = ntile * 128;
        f32x4 acc[2][4]; float ssq[2] = {0.f, 0.f}; acc_zero(acc);
        gemm_main<false>(F.lds, acc, ssq, APlain{Hb, D}, Wb + WO_G, D, D, m0, n0, false);
#pragma unroll
        for (int mt = 0; mt < 2; ++mt) { const int row = m0 + 32 * wm + 16 * mt + lr;
#pragma unroll
            for (int nt = 0; nt < 4; ++nt) { const int col = n0 + 64 * wn + 16 * nt + 4 * g; const f32x4 b = *(const f32x4*)(bg + col); f32x4 o;
#pragma unroll
                for (int r = 0; r < 4; ++r) o[r] = sigm(acc[mt][nt][r] + b[r]);
                *(u32x2*)(gates + (size_t)row * 4096 + col) = pk4(o); } }
    }
}
__device__ __forceinline__ void ph_merge() {
    const Frame F = mkframe(); unsigned char* const WS = aws(); float* const OUTP = aout(); (void)WS; (void)OUTP;
    const bf16_t* br = (const bf16_t*)(WS + WS_BR); const bf16_t* Wb = (const bf16_t*)(WS + WS_W);
    const bf16_t* gates = (const bf16_t*)(WS + WS_G); bf16_t* Hb = (bf16_t*)(WS + WS_H);
    const int lr = F.lane & 15, g = F.lane >> 4, wm = F.wave >> 1, wn = F.wave & 1;
    for (int it = F.bid; it < 160 * 8; it += F.G) {
        const int mtile = it >> 3, ntile = it & 7, m0 = mtile * 128, n0 = ntile * 128;
        f32x4 macc[2][4]; acc_zero(macc);
#pragma unroll 1
        for (int n = 0; n < 4; ++n) {
            f32x4 acc[2][4]; float ssq[2] = {0.f, 0.f}; acc_zero(acc);
            gemm_main<false>(F.lds, acc, ssq, APlain{br + 256 * n, D}, Wb + WO_BR + (size_t)n * 1024 * 256, 256, 256, m0, n0, false);
#pragma unroll
            for (int mt = 0; mt < 2; ++mt) { const int row = m0 + 32 * wm + 16 * mt + lr;
#pragma unroll
                for (int nt = 0; nt < 4; ++nt) { const int col = n0 + 64 * wn + 16 * nt + 4 * g;
                    macc[mt][nt] += up4(*(const u32x2*)(gates + (size_t)row * 4096 + n * 1024 + col)) * acc[mt][nt]; } }
        }
#pragma unroll
        for (int mt = 0; mt < 2; ++mt) { const int row = m0 + 32 * wm + 16 * mt + lr;
#pragma unroll
            for (int nt = 0; nt < 4; ++nt) *(u32x2*)(Hb + (size_t)row * D + n0 + 64 * wn + 16 * nt + 4 * g) = pk4(macc[mt][nt]); }
    }
}

__device__ __forceinline__ void ph_m1(int l) {
    const Frame F = mkframe(); unsigned char* const WS = aws(); float* const OUTP = aout(); (void)WS; (void)OUTP;
    const bf16_t* Wb = (const bf16_t*)(WS + WS_W);
    bf16_t* proj = (bf16_t*)(WS + WS_G + GO_PROJ); bf16_t* Qb = (bf16_t*)(WS + WS_G + GO_QB); bf16_t* Kb = (bf16_t*)(WS + WS_G + GO_KB); bf16_t* Vt = (bf16_t*)(WS + WS_G + GO_VT);
    const bf16_t* rkT = (const bf16_t*)(WS + WS_G + GO_RKT); const bf16_t* rvT = (const bf16_t*)(WS + WS_G + GO_RVT);
    float* retkv = (float*)(WS + WS_G + GO_RETKV); float* s5loc = (float*)(WS + WS_G + GO_S5LOC);
    bf16_t* br = (bf16_t*)(WS + WS_BR);
    const float* rMc = (const float*)(WS + WS_ROPE) + 131072; const float* rMs = rMc + 32768;
    const bf16_t* ctxA = (const bf16_t*)(WS + WS_CTXA) + (size_t)l * 4096 * 128;
    const int lr = F.lane & 15, g = F.lane >> 4, wm = F.wave >> 1, wn = F.wave & 1;

    for (int it = F.bid; it < 160 * 3; it += F.G) {
        const int mtile = it / 3, ntile = it - mtile * 3, m0 = mtile * 128, n0 = ntile * 128;
        f32x4 acc[2][4]; float ssq[2] = {0.f, 0.f}; acc_zero(acc);
        gemm_main<true>(F.lds, acc, ssq, APlain{proj + PC_CQ, PLD}, Wb + WO_UQ, 192, 192, m0, n0, false);
        ssq_finish(ssq);
        const bool samp = m0 >= NPT;
#pragma unroll
        for (int mt = 0; mt < 2; ++mt) {
            const int tok = m0 + 32 * wm + 16 * mt + lr, t = tok_t(tok); const float sc = rsqrtf(ssq[mt] * (1.0f / 192.0f) + EPS) * QSCALE;
#pragma unroll
            for (int nt = 0; nt < 4; ++nt) acc[mt][nt] = acc[mt][nt] * sc;
            if (samp) {
#pragma unroll
                for (int nt = 0; nt < 4; nt += 2) { const int colb = n0 + 64 * wn + 16 * nt;
                    if (colb % 96 == 64) { const f32x4 c = *(const f32x4*)(rMc + t * 16 + 4 * g), s = *(const f32x4*)(rMs + t * 16 + 4 * g);
                        const f32x4 x1 = acc[mt][nt], x2 = acc[mt][nt + 1]; acc[mt][nt] = x1 * c - x2 * s; acc[mt][nt + 1] = x1 * s + x2 * c; } }
            }
#pragma unroll
            for (int nt = 0; nt < 4; ++nt) *(u32x2*)(Qb + (size_t)tok * 384 + n0 + 64 * wn + 16 * nt + 4 * g) = pk4(acc[mt][nt]);
        }
    }
    for (int it = F.bid; it < 192 * 2; it += F.G) {
        const int mtile = it >> 1, ntile = it & 1, n0 = ntile * 128; const bool ctx = mtile >= 160; const int m0 = (ctx ? mtile - 160 : mtile) * 128;
        f32x4 acc[2][4]; float ssq[2] = {0.f, 0.f}; acc_zero(acc);
        if (!ctx) { gemm_main<true>(F.lds, acc, ssq, APlain{proj + PC_CKV, PLD}, Wb + WO_UK, 128, 128, m0, n0, false); ssq_finish(ssq); }
        else gemm_main<false>(F.lds, acc, ssq, APlain{ctxA, 128}, Wb + WO_UKC, 128, 128, m0, n0, false);
        const int head = (n0 + 64 * wn) >> 6;
#pragma unroll
        for (int mt = 0; mt < 2; ++mt) {
            const int row = m0 + 32 * wm + 16 * mt + lr; int keyrow; float sc;
            if (!ctx) { keyrow = tok_keyrow(row); sc = rsqrtf(ssq[mt] * (1.0f / 128.0f) + EPS); } else { keyrow = NPT + (row >> 9) * 2560 + 2048 + (row & 511); sc = 1.0f; }
            bf16_t* kd = Kb + (size_t)keyrow * 384 + head * 96;
#pragma unroll
            for (int nt = 0; nt < 4; ++nt) *(u32x2*)(kd + 16 * nt + 4 * g) = pk4(acc[mt][nt] * sc);
#pragma unroll
            for (int nt = 0; nt < 2; ++nt) {
                u32x2 kr;
                if (!ctx) kr = *(const u32x2*)(proj + (size_t)row * PLD + PC_KR + 16 * nt + 4 * g);
                else kr = pk4(*(const f32x4*)(ain(4) + ((size_t)((row >> 9) * 2 + l) * 512 + (row & 511)) * 160 + 128 + 16 * nt + 4 * g));
                *(u32x2*)(kd + 64 + 16 * nt + 4 * g) = kr;
            }
        }
    }
    for (int it = F.bid; it < 192 * 2; it += F.G) {
        const int mtile = it >> 1, ntile = it & 1, n0 = ntile * 128; const bool ctx = mtile >= 160; const int m0 = (ctx ? mtile - 160 : mtile) * 128;
        f32x4 acc[2][4]; float ssq[2] = {0.f, 0.f}; acc_zero(acc);
        if (!ctx) { gemm_main<true>(F.lds, acc, ssq, APlain{proj + PC_CKV, PLD}, Wb + WO_UV, 128, 128, m0, n0, true); ssq_finish(ssq); }
        else gemm_main<false>(F.lds, acc, ssq, APlain{ctxA, 128}, Wb + WO_UVC, 128, 128, m0, n0, true);
        const int head = (n0 + 64 * wn) >> 6;
#pragma unroll
        for (int mt = 0; mt < 2; ++mt) {
            const int row0 = m0 + 32 * wm + 16 * mt + 4 * g; int s, key0;
            if (!ctx) { s = tok_seq(row0); key0 = tok_t(row0); } else { s = 16 + (row0 >> 9); key0 = 2048 + (row0 & 511); }
            f32x4 sc;
#pragma unroll
            for (int r = 0; r < 4; ++r) { const float q = __shfl(ssq[mt], 4 * g + r); sc[r] = ctx ? 1.0f : rsqrtf(q * (1.0f / 128.0f) + EPS); }
            const int S = seq_keys(s); bf16_t* vb = Vt + (size_t)seq_kbase(s) * 256;
#pragma unroll
            for (int nt = 0; nt < 4; ++nt) *(u32x2*)(vb + (size_t)(head * 64 + 16 * nt + lr) * S + key0) = pk4(acc[mt][nt] * sc);
        }
    }
    for (int it = F.bid; it < 16 * 5 * 2; it += F.G) {
        const int gg = it / 10, r10 = it - gg * 10, m0 = (r10 >> 1) * 128, n0 = (r10 & 1) * 128;
        f32x4 acc[2][4]; float ssq[2] = {0.f, 0.f}; acc_zero(acc);
        gemm_main<false>(F.lds, acc, ssq, AS5U{proj, gg}, Wb + WO_S5WS + (size_t)gg * 256 * 512, 512, 512, m0, n0, false);
#pragma unroll
        for (int mt = 0; mt < 2; ++mt) { const int c = m0 + 32 * wm + 16 * mt + lr;
#pragma unroll
            for (int nt = 0; nt < 4; ++nt) *(f32x4*)(s5loc + ((size_t)c * 16 + gg) * 256 + n0 + 64 * wn + 16 * nt + 4 * g) = acc[mt][nt]; }
    }
    for (int it = F.bid; it < 160 * 4; it += F.G) {
        const int c = it >> 2, h = it & 3, d = F.wave >> 2, dvb = F.wave & 3;
        const float dl = ain(24)[(l * 2 + d) * 4 + h]; const float lg2 = -log1pf(expf(-dl)) * 1.4426950408889634f;
        f32x4 acc[4];
#pragma unroll
        for (int x = 0; x < 4; ++x) acc[x] = (f32x4){0.f, 0.f, 0.f, 0.f};
#pragma unroll
        for (int ks = 0; ks < 4; ++ks) {
            float w[8];
#pragma unroll
            for (int e = 0; e < 8; ++e) { const int j = 32 * ks + 8 * g + e; w[e] = exp2f(lg2 * (float)(d == 0 ? 127 - j : j)); }
            const bf16x8 vf = *(const bf16x8*)(rvT + (((size_t)c * 4 + h) * 64 + 16 * dvb + lr) * 128 + 32 * ks + 8 * g);
#pragma unroll
            for (int x = 0; x < 4; ++x) {
                const u32x4 kr = *(const u32x4*)(rkT + (((size_t)c * 4 + h) * 64 + 16 * x + lr) * 128 + 32 * ks + 8 * g);
                u32x4 ks4; ks4.x = pk2(bflo(kr.x) * w[0], bfhi(kr.x) * w[1]); ks4.y = pk2(bflo(kr.y) * w[2], bfhi(kr.y) * w[3]);
                ks4.z = pk2(bflo(kr.z) * w[4], bfhi(kr.z) * w[5]); ks4.w = pk2(bflo(kr.w) * w[6], bfhi(kr.w) * w[7]);
                acc[x] = __builtin_amdgcn_mfma_f32_16x16x32_bf16(__builtin_bit_cast(bf16x8, ks4), vf, acc[x], 0, 0, 0);
            }
        }
#pragma unroll
        for (int x = 0; x < 4; ++x) *(f32x4*)(retkv + ((((size_t)c * 4 + h) * 2 + d) * 64 + 16 * dvb + lr) * 64 + 16 * x + 4 * g) = acc[x];
    }
    {
        const float* cw = ain(26) + l * 768; const float* cbias = ain(27) + l * 256;
        for (int i = F.gt; i < NTOK * 32; i += F.NGT) {
            const int tok = i >> 5, c0 = (i & 31) * 8, t = tok_t(tok), T = seq_len(tok_seq(tok));
            float z[3][8];
#pragma unroll
            for (int dtk = 0; dtk < 3; ++dtk) {
                const int tt = t + dtk - 1;
                if (tt >= 0 && tt < T) { const u32x4 a = *(const u32x4*)(proj + (size_t)(tok + dtk - 1) * PLD + PC_CC + c0), b = *(const u32x4*)(proj + (size_t)(tok + dtk - 1) * PLD + PC_CX + c0);
                    z[dtk][0] = bflo(a.x) * bflo(b.x); z[dtk][1] = bfhi(a.x) * bfhi(b.x); z[dtk][2] = bflo(a.y) * bflo(b.y); z[dtk][3] = bfhi(a.y) * bfhi(b.y);
                    z[dtk][4] = bflo(a.z) * bflo(b.z); z[dtk][5] = bfhi(a.z) * bfhi(b.z); z[dtk][6] = bflo(a.w) * bflo(b.w); z[dtk][7] = bfhi(a.w) * bfhi(b.w); }
                else {
#pragma unroll
                    for (int e = 0; e < 8; ++e) z[dtk][e] = 0.f; }
            }
            const u32x4 gb = *(const u32x4*)(proj + (size_t)tok * PLD + PC_CB + c0);
            float gv[8] = {bflo(gb.x), bfhi(gb.x), bflo(gb.y), bfhi(gb.y), bflo(gb.z), bfhi(gb.z), bflo(gb.w), bfhi(gb.w)};
            float o[8];
#pragma unroll
            for (int e = 0; e < 8; ++e) o[e] = gv[e] * (cbias[c0 + e] + z[0][e] * cw[c0 + e] + z[1][e] * cw[256 + c0 + e] + z[2][e] * cw[512 + c0 + e]);
            u32x4 ov; ov.x = pk2(o[0], o[1]); ov.y = pk2(o[2], o[3]); ov.z = pk2(o[4], o[5]); ov.w = pk2(o[6], o[7]);
            *(u32x4*)(br + (size_t)tok * D + 512 + c0) = ov;
        }
    }
    for (int tok = F.gw; tok < NPT; tok += F.NGW) {
        const unsigned cv = *(const unsigned*)(proj + (size_t)tok * PLD + PC_CKV + 2 * F.lane);
        const float a = bflo(cv), b = bfhi(cv); const float rstd = rsqrtf(wave_sum(a * a + b * b) * (1.0f / 128.0f) + EPS);
        float* o = OUTP + OUT_CACHE + ((size_t)((tok >> 8) * 2 + l) * 256 + (tok & 255)) * 160;
        o[2 * F.lane] = a * rstd * ain(30)[l * 128 + 2 * F.lane]; o[2 * F.lane + 1] = b * rstd * ain(30)[l * 128 + 2 * F.lane + 1];
        if (F.lane < 32) o[128 + F.lane] = bf1(proj[(size_t)tok * PLD + PC_KR + F.lane]);
    }
}

constexpr int AT_KROW = 208, AT_VROW = 144, AT_KBYTES = 64 * AT_KROW, AT_VBYTES = 64 * AT_VROW;
__device__ __forceinline__ void ph_m2(int l) {
    const Frame F = mkframe(); unsigned char* const WS = aws(); float* const OUTP = aout(); (void)WS; (void)OUTP;
    const bf16_t* Qb = (const bf16_t*)(WS + WS_G + GO_QB); const bf16_t* Kb = (const bf16_t*)(WS + WS_G + GO_KB); const bf16_t* Vt = (const bf16_t*)(WS + WS_G + GO_VT);
    bf16_t* br = (bf16_t*)(WS + WS_BR);
    const int lr = F.lane & 15, g = F.lane >> 4;
    for (int it = F.bid; it < 640; it += F.G) {
        int s, h, qb;
        if (it < 512) { s = 16 + (it >> 6); h = (it >> 4) & 3; qb = it & 15; } else { const int j = it - 512; s = j >> 3; h = (j >> 1) & 3; qb = j & 1; }
        const int S = seq_keys(s), kbase = seq_kbase(s), tok0 = seq_start(s) + qb * 128 + 16 * F.wave, nkt = S >> 6;
        bf16x8 qf[3];
#pragma unroll
        for (int ks = 0; ks < 3; ++ks) qf[ks] = *(const bf16x8*)(Qb + (size_t)(tok0 + lr) * 384 + h * 96 + 32 * ks + 8 * g);
        f32x4 oacc[4];
#pragma unroll
        for (int db = 0; db < 4; ++db) oacc[db] = (f32x4){0.f, 0.f, 0.f, 0.f};
        float m_run = -1e30f, l_run = 0.f;
        const bf16_t* vsrc = Vt + (size_t)kbase * 256 + (size_t)(h * 64) * S;
        for (int kt = 0; kt < nkt; ++kt) {
            __syncthreads();
            for (int q = F.tid; q < 768; q += NTHR) { const int key = q / 12, c12 = q - key * 12;
                *(LAS u32x4*)(F.lds + key * AT_KROW + c12 * 16) = *(const u32x4*)(Kb + (size_t)(kbase + kt * 64 + key) * 384 + h * 96 + c12 * 8); }
            { const int dv = F.tid >> 3, c8 = F.tid & 7;
              *(LAS u32x4*)(F.lds + AT_KBYTES + dv * AT_VROW + c8 * 16) = *(const u32x4*)(vsrc + (size_t)dv * S + kt * 64 + c8 * 8); }
            __syncthreads();
            f32x4 sacc[4];
#pragma unroll
            for (int kb = 0; kb < 4; ++kb) { sacc[kb] = (f32x4){0.f, 0.f, 0.f, 0.f};
#pragma unroll
                for (int ks = 0; ks < 3; ++ks) { const bf16x8 kf = *(const LAS bf16x8*)(F.lds + (16 * kb + lr) * AT_KROW + (4 * ks + g) * 16);
                    sacc[kb] = __builtin_amdgcn_mfma_f32_16x16x32_bf16(kf, qf[ks], sacc[kb], 0, 0, 0); } }
            float mx = -1e30f;
#pragma unroll
            for (int kb = 0; kb < 4; ++kb)
#pragma unroll
                for (int r = 0; r < 4; ++r) mx = fmaxf(mx, sacc[kb][r]);
            mx = fmaxf(mx, __shfl_xor(mx, 16)); mx = fmaxf(mx, __shfl_xor(mx, 32));
            const float m_new = fmaxf(m_run, mx), alpha = exp2f(m_run - m_new); m_run = m_new;
            float ls = 0.f;
#pragma unroll
            for (int kb = 0; kb < 4; ++kb)
#pragma unroll
                for (int r = 0; r < 4; ++r) { const float e = exp2f(sacc[kb][r] - m_new); sacc[kb][r] = e; ls += e; }
            l_run = l_run * alpha + ls;
#pragma unroll
            for (int r = 0; r < 4; ++r) { const float a = __shfl(alpha, 4 * g + r);
#pragma unroll
                for (int db = 0; db < 4; ++db) oacc[db][r] *= a; }
#pragma unroll
            for (int ks2 = 0; ks2 < 2; ++ks2) {
                u32x4 pw; pw.x = pk2(sacc[2 * ks2][0], sacc[2 * ks2][1]); pw.y = pk2(sacc[2 * ks2][2], sacc[2 * ks2][3]);
                pw.z = pk2(sacc[2 * ks2 + 1][0], sacc[2 * ks2 + 1][1]); pw.w = pk2(sacc[2 * ks2 + 1][2], sacc[2 * ks2 + 1][3]);
                const bf16x8 pf = __builtin_bit_cast(bf16x8, pw);
#pragma unroll
                for (int db = 0; db < 4; ++db) {
                    const LAS unsigned char* vp = F.lds + AT_KBYTES + (16 * db + lr) * AT_VROW + (32 * ks2 + 4 * g) * 2;
                    const u32x2 v0 = *(const LAS u32x2*)vp, v1 = *(const LAS u32x2*)(vp + 32);
                    u32x4 vw; vw.x = v0.x; vw.y = v0.y; vw.z = v1.x; vw.w = v1.y;
                    oacc[db] = __builtin_amdgcn_mfma_f32_16x16x32_bf16(pf, __builtin_bit_cast(bf16x8, vw), oacc[db], 0, 0, 0);
                }
            }
        }
        float lt = l_run; lt += __shfl_xor(lt, 16); lt += __shfl_xor(lt, 32);
        const float linv = 1.0f / lt;
#pragma unroll
        for (int r = 0; r < 4; ++r) { const float li = __shfl(linv, 4 * g + r); bf16_t* o = br + (size_t)(tok0 + 4 * g + r) * D + 768 + h * 64 + lr;
#pragma unroll
            for (int db = 0; db < 4; ++db) o[16 * db] = (bf16_t)f2bf(oacc[db][r] * li); }
    }
    __syncthreads();
    {
        const float* pw = (const float*)(WS + WS_S5PW); const float* s5loc = (const float*)(WS + WS_G + GO_S5LOC); bf16_t* s5sin = (bf16_t*)(WS + WS_G + GO_S5SIN);
        for (int i = F.gt; i < 24 * 2048; i += F.NGT) {
            const int q = i & 63, gg = (i >> 6) & 15, d = (i >> 10) & 1, s = i >> 11;
            const size_t ch = ((size_t)(l * 2 + d) * 16 + gg) * 64 + q; const float ar = pw[(ch * 33 + 32) * 2], ai = pw[(ch * 33 + 32) * 2 + 1];
            float sr = 0.f, si = 0.f;
            if (s >= 16) { const float* s0 = ain(2) + ((((size_t)(s - 16) * 2 + l) * 2 + d) * 16 + gg) * 128 + q * 2; sr = s0[0]; si = s0[1]; }
            const int nc = seq_len(s) >> 5, c0 = seq_start(s) >> 5;
            for (int k = 0; k < nc; ++k) {
                const int c = c0 + (d == 0 ? k : nc - 1 - k); const size_t o = ((size_t)c * 16 + gg) * 256 + d * 128 + q;
                s5sin[o] = (bf16_t)f2bf(sr); s5sin[o + 64] = (bf16_t)f2bf(si);
                const float lr_ = s5loc[o], li_ = s5loc[o + 64];
                const float nr = ar * sr - ai * si + lr_, ni = ar * si + ai * sr + li_; sr = nr; si = ni;
            }
            if (s < 16) { float* o = OUTP + OUT_S5 + ((((size_t)s * 2 + l) * 2 + d) * 16 + gg) * 128 + q * 2; o[0] = sr; o[1] = si; }
        }
    }
    {
        const float* retkv = (const float*)(WS + WS_G + GO_RETKV); bf16_t* retsin = (bf16_t*)(WS + WS_G + GO_RETSIN);
        for (int i = F.gt; i < 24 * 8 * 4096; i += F.NGT) {
            const int e = i & 4095, d = (i >> 12) & 1, h = (i >> 13) & 3, s = i >> 15, dv = e >> 6, dk = e & 63;
            const float dl = ain(24)[(l * 2 + d) * 4 + h]; const float g128 = exp2f(-log1pf(expf(-dl)) * 1.4426950408889634f * 128.0f);
            float S = 0.f;
            if (s >= 16) S = ain(3)[(((((size_t)(s - 16) * 2 + l) * 2 + d) * 4 + h) * 64 + dk) * 64 + dv];
            const int nc = seq_len(s) >> 7, c0 = seq_start(s) >> 7;
            for (int k = 0; k < nc; ++k) {
                const int c = c0 + (d == 0 ? k : nc - 1 - k); const size_t o = (((size_t)c * 4 + h) * 2 + d) * 4096 + e;
                retsin[o] = (bf16_t)f2bf(S);
                S = g128 * S + retkv[o];
            }
            if (s < 16) OUTP[OUT_RET + (((((size_t)s * 2 + l) * 2 + d) * 4 + h) * 64 + dk) * 64 + dv] = S;
        }
    }
}

__device__ __forceinline__ void ph_m3(int l) {
    const Frame F = mkframe(); unsigned char* const WS = aws(); float* const OUTP = aout(); (void)WS; (void)OUTP;
    const bf16_t* Wb = (const bf16_t*)(WS + WS_W); const bf16_t* proj = (const bf16_t*)(WS + WS_G + GO_PROJ);
    const bf16_t* s5sin = (const bf16_t*)(WS + WS_G + GO_S5SIN); bf16_t* zb = (bf16_t*)(WS + WS_G + GO_S5LOC);
    const bf16_t* rvT = (const bf16_t*)(WS + WS_G + GO_RVT); const bf16_t* retsin = (const bf16_t*)(WS + WS_G + GO_RETSIN);
    bf16_t* br = (bf16_t*)(WS + WS_BR);
    const int lr = F.lane & 15, g = F.lane >> 4, wm = F.wave >> 1, wn = F.wave & 1;
    for (int it = F.bid; it < 16 * 5 * 4; it += F.G) {
        const int gg = it / 20, r20 = it - gg * 20, m0 = (r20 >> 2) * 128, n0 = (r20 & 3) * 128;
        f32x4 acc[2][4]; float ssq[2] = {0.f, 0.f}; acc_zero(acc);
        gemm_main<false>(F.lds, acc, ssq, AS5U{proj, gg}, Wb + WO_S5T + (size_t)gg * 512 * 512, 512, 512, m0, n0, false);
        gemm_main<false>(F.lds, acc, ssq, APlain{s5sin + gg * 256, 16 * 256}, Wb + WO_S5WO + (size_t)gg * 512 * 256, 256, 256, m0, n0, false);
#pragma unroll
        for (int mt = 0; mt < 2; ++mt) { const int c = m0 + 32 * wm + 16 * mt + lr;
#pragma unroll
            for (int nt = 0; nt < 4; ++nt) { const int n = n0 + 64 * wn + 16 * nt + 4 * g, t = n >> 4, h = n & 15; f32x4 z;
#pragma unroll
                for (int r = 0; r < 4; ++r) z[r] = gelu_t(acc[mt][nt][r]);
                *(u32x2*)(zb + (size_t)(c * 32 + t) * 256 + 16 * gg + h) = pk4(z); } }
    }
    for (int it = F.bid; it < 160 * 4; it += F.G) {
        const int c = it >> 2, h = it & 3, tokq = c * 128 + 16 * F.wave;
        const float lgf = -log1pf(expf(-ain(24)[(l * 2 + 0) * 4 + h])) * 1.4426950408889634f, lgb = -log1pf(expf(-ain(24)[(l * 2 + 1) * 4 + h])) * 1.4426950408889634f;
        bf16x8 qf[2];
#pragma unroll
        for (int ks = 0; ks < 2; ++ks) qf[ks] = *(const bf16x8*)(proj + (size_t)(tokq + lr) * PLD + PC_RQ + h * 64 + 32 * ks + 8 * g);
        f32x4 oacc[4], sfa[4], sba[4];
#pragma unroll
        for (int db = 0; db < 4; ++db) { oacc[db] = (f32x4){0.f, 0.f, 0.f, 0.f}; sfa[db] = oacc[db]; sba[db] = oacc[db]; }
        const int jq = 16 * F.wave + lr;
#pragma unroll 1
        for (int ks2 = 0; ks2 < 4; ++ks2) {
            f32x4 sa[2];
#pragma unroll
            for (int b2 = 0; b2 < 2; ++b2) { const int kb = 2 * ks2 + b2; sa[b2] = (f32x4){0.f, 0.f, 0.f, 0.f};
#pragma unroll
                for (int ks = 0; ks < 2; ++ks) { const bf16x8 kf = *(const bf16x8*)(proj + (size_t)(c * 128 + 16 * kb + lr) * PLD + PC_RK + h * 64 + 32 * ks + 8 * g);
                    sa[b2] = __builtin_amdgcn_mfma_f32_16x16x32_bf16(kf, qf[ks], sa[b2], 0, 0, 0); }
#pragma unroll
                for (int r = 0; r < 4; ++r) { const int ik = 16 * kb + 4 * g + r; const float dec = ik <= jq ? exp2f(lgf * (float)(jq - ik)) : exp2f(lgb * (float)(ik - jq)); sa[b2][r] *= dec; }
            }
            u32x4 pw; pw.x = pk2(sa[0][0], sa[0][1]); pw.y = pk2(sa[0][2], sa[0][3]); pw.z = pk2(sa[1][0], sa[1][1]); pw.w = pk2(sa[1][2], sa[1][3]);
            const bf16x8 pf = __builtin_bit_cast(bf16x8, pw);
#pragma unroll
            for (int db = 0; db < 4; ++db) {
                const bf16_t* vp = rvT + (((size_t)c * 4 + h) * 64 + 16 * db + lr) * 128 + 32 * ks2 + 4 * g;
                const u32x2 v0 = *(const u32x2*)vp, v1 = *(const u32x2*)(vp + 16);
                u32x4 vw; vw.x = v0.x; vw.y = v0.y; vw.z = v1.x; vw.w = v1.y;
                oacc[db] = __builtin_amdgcn_mfma_f32_16x16x32_bf16(pf, __builtin_bit_cast(bf16x8, vw), oacc[db], 0, 0, 0);
            }
        }
#pragma unroll
        for (int ks = 0; ks < 2; ++ks)
#pragma unroll
            for (int db = 0; db < 4; ++db) {
                const bf16x8 s0 = *(const bf16x8*)(retsin + ((((size_t)c * 4 + h) * 2 + 0) * 64 + 16 * db + lr) * 64 + 32 * ks + 8 * g);
                const bf16x8 s1 = *(const bf16x8*)(retsin + ((((size_t)c * 4 + h) * 2 + 1) * 64 + 16 * db + lr) * 64 + 32 * ks + 8 * g);
                sfa[db] = __builtin_amdgcn_mfma_f32_16x16x32_bf16(qf[ks], s0, sfa[db], 0, 0, 0);
                sba[db] = __builtin_amdgcn_mfma_f32_16x16x32_bf16(qf[ks], s1, sba[db], 0, 0, 0);
            }
#pragma unroll
        for (int r = 0; r < 4; ++r) {
            const int jo = 16 * F.wave + 4 * g + r, tok = c * 128 + jo;
            const float qdf = exp2f(lgf * (float)(jo + 1)), qdb = exp2f(lgb * (float)(128 - jo));
            float o[4], sum = 0.f;
#pragma unroll
            for (int db = 0; db < 4; ++db) { o[db] = oacc[db][r] + qdf * sfa[db][r] + qdb * sba[db][r]; sum += o[db]; }
            sum += __shfl_xor(sum, 1); sum += __shfl_xor(sum, 2); sum += __shfl_xor(sum, 4); sum += __shfl_xor(sum, 8);
            const float mu = sum * (1.0f / 64.0f); float var = 0.f;
#pragma unroll
            for (int db = 0; db < 4; ++db) { o[db] -= mu; var += o[db] * o[db]; }
            var += __shfl_xor(var, 1); var += __shfl_xor(var, 2); var += __shfl_xor(var, 4); var += __shfl_xor(var, 8);
            const float rstd = rsqrtf(var * (1.0f / 64.0f) + EPS);
#pragma unroll
            for (int db = 0; db < 4; ++db) { const int ch = h * 64 + 16 * db + lr;
                const float rg = bf1(proj[(size_t)tok * PLD + PC_RG + ch]);
                br[(size_t)tok * D + 256 + ch] = (bf16_t)f2bf(o[db] * rstd * ain(25)[l * 256 + ch] * silu(rg)); }
        }
    }
}

#ifndef DIAG_OFF
#define DIAG_OFF (WS_H)
#endif
__device__ __forceinline__ void diag_dump() {
    const Frame F = mkframe(); unsigned char* const WS = aws(); float* const OUTP = aout();
    const unsigned* src = (const unsigned*)WS;
    for (size_t i = F.gt; i < 23461888; i += F.NGT) {
        float a = 0.f;
#pragma unroll
        for (int k = 0; k < 4; ++k) { const size_t w = i + (size_t)k * 23461888; if (w >= 262144 && w < (WS_END >> 2)) { const unsigned u = src[w]; a += (float)(u & 0xffffu) * 1e-4f + (float)(u >> 16) * 1e-4f; } }
        OUTP[i] = a;
    }
}
constexpr int LDS_BYTES = 147456;
__global__ void __launch_bounds__(NTHR, 2) hybrid_fwd(Params p) {
    unsigned char* const WS = aws();
    const Frame F = mkframe();
    volatile LAS unsigned* misc = (volatile LAS unsigned*)(F.lds + LDS_BYTES - 64);
    if (F.tid < 16) misc[F.tid] = 0u;
    __syncthreads();
    XcdBarrier bar = xcd_barrier_post((unsigned*)(WS + WS_CTL) + CW_BAR, misc);
#define GRID_BAR() do { xcd_barrier(bar); CUT_CHECK(); } while (0)
    const float* mod = (const float*)(WS + WS_MOD);
    const bf16_t* Wb = (const bf16_t*)(WS + WS_W);
    bf16_t* Hb = (bf16_t*)(WS + WS_H); bf16_t* BRb = (bf16_t*)(WS + WS_BR); bf16_t* Gb = (bf16_t*)(WS + WS_G);

#define DIAG_CUT 999
#ifndef DIAG_CUT
#define DIAG_CUT 999
#endif
    int phase_no = 0;
#define CUT_CHECK() do { if (++phase_no == DIAG_CUT) { diag_dump(); return; } } while (0)
    if (DIAG_CUT == 0) { diag_dump(); return; }
    ph_mod(); ph_tables(); ph_wprep(0);
    GRID_BAR();
    ph_s5k();
    ph_rowpass<true, false, true>(nullptr, nullptr, nullptr, 0, 0.f, ain(9), mod, 0, 1);
    GRID_BAR();
#pragma unroll 1
    for (int l = 0; l < 2; ++l) {
        const float* modl = mod + (size_t)l * 9 * 9216;
        ph_ffn_up(0);
        if (l == 0) ph_s5mat(0);
        GRID_BAR();
        ph_gemm_n1024(Gb, FF, Wb + WO_2A, BRb);
        GRID_BAR();
        if (l == 0) ph_rowpass<true, true, true>(BRb, ain(10) + (l * 3 + 0) * D, modl, 2, 0.5f, ain(9) + (l * 3 + 1) * D, modl, 3, 4);
        else        ph_rowpass<false, true, true>(BRb, ain(10) + (l * 3 + 0) * D, modl, 2, 0.5f, ain(9) + (l * 3 + 1) * D, modl, 3, 4);
        GRID_BAR();
        ph_win();
        GRID_BAR();
        ph_m1(l);
        GRID_BAR();
        ph_m2(l);
        GRID_BAR();
        ph_m3(l);
        GRID_BAR();
        ph_gate(l); ph_gate2(l);
        GRID_BAR();
        ph_merge();
        GRID_BAR();
        ph_gemm_n1024(Hb, D, Wb + WO_O, BRb);
        GRID_BAR();
        ph_rowpass<false, true, true>(BRb, ain(10) + (l * 3 + 1) * D, modl, 5, 1.0f, ain(9) + (l * 3 + 2) * D, modl, 6, 7);
        GRID_BAR();
        ph_ffn_up(1);
        GRID_BAR();
        ph_gemm_n1024(Gb, FF, Wb + WO_2B, BRb);
        GRID_BAR();
        if (l == 0) {
            ph_rowpass<false, true, true>(BRb, ain(10) + (l * 3 + 2) * D, modl, 8, 0.5f, ain(9) + 3 * D, mod + (size_t)9 * 9216, 0, 1);
            ph_wprep(1); ph_s5mat(1);
            GRID_BAR();
        } else {
            ph_rowpass<false, true, false>(BRb, ain(10) + (l * 3 + 2) * D, modl, 8, 0.5f, nullptr, nullptr, 0, 0);
        }
    }
}

extern "C" void kernel_launch(void* const* d_in, const int* in_sizes, int n_in, void* d_out, int out_size, void* d_ws, size_t ws_size, hipStream_t stream) {
    static int grid = 0;
    if (grid == 0) {
        if (n_in != 36 || out_size != 23461888 || ws_size < WS_END) { fprintf(stderr, "kernel_launch: unexpected problem shape (n_in %d, out %d, ws %zu; need ws >= %zu)\n", n_in, out_size, ws_size, (size_t)WS_END); grid = -1; return; }
        int dev = 0, cus = 0, per_cu = 0;
        if (hipGetDevice(&dev) != hipSuccess || hipDeviceGetAttribute(&cus, hipDeviceAttributeMultiprocessorCount, dev) != hipSuccess) { grid = -1; return; }
        if (hipFuncSetAttribute((const void*)hybrid_fwd, hipFuncAttributeMaxDynamicSharedMemorySize, LDS_BYTES) != hipSuccess) { fprintf(stderr, "kernel_launch: hipFuncSetAttribute failed\n"); grid = -1; return; }
        if (hipOccupancyMaxActiveBlocksPerMultiprocessor(&per_cu, (const void*)hybrid_fwd, NTHR, LDS_BYTES) != hipSuccess || per_cu < 1)
            fprintf(stderr, "kernel_launch: occupancy query reports %d blocks/CU\n", per_cu);
        (void)hipGetLastError();
        grid = cus;
    }
    if (grid < 0) return;
    (void)hipMemsetAsync((char*)d_ws + WS_CTL, 0, 65536, stream);
    Params prm{};
    for (int i = 0; i < 36; ++i) prm.in[i] = (const float*)d_in[i];
    prm.out = (float*)d_out; prm.ws = (unsigned char*)d_ws;
    hipLaunchKernelGGL(hybrid_fwd, dim3(grid), dim3(NTHR), LDS_BYTES, stream, prm);
}
```

```cpp
#include <hip/hip_runtime.h>
#include <cstdio>
#include <cstdint>

#define LAS __attribute__((address_space(3)))
typedef unsigned short bf16_t;
typedef short bf16x8 __attribute__((ext_vector_type(8)));
typedef float f32x4 __attribute__((ext_vector_type(4)));
typedef unsigned u32x4 __attribute__((ext_vector_type(4)));
typedef unsigned u32x2 __attribute__((ext_vector_type(2)));

constexpr int D = 1024, NTOK = 20480, NPT = 4096, FF = 2816, NWAVES = 8, NTHR = 512;
constexpr int PLD = 2176;
constexpr float EPS = 1e-6f;
constexpr int PC_U = 0, PC_RQ = 256, PC_RK = 512, PC_RG = 768, PC_CX = 1024, PC_CB = 1280, PC_CC = 1536, PC_CQ = 1792, PC_CKV = 1984, PC_KR = 2112;
constexpr float QSCALE = 0.10206207261596577f * 1.4426950408889634f;

constexpr size_t MiB = 1u << 20;
constexpr size_t WS_CTL = 0, CTL_BYTES = 1 * MiB;
constexpr size_t WS_MOD = 1 * MiB;
constexpr size_t WS_ROPE = 2 * MiB;
constexpr size_t WS_CTXA = 3 * MiB;
constexpr size_t WS_S5PW = 5 * MiB;
constexpr size_t WS_S5BB = WS_S5PW + 1081344;
constexpr size_t WS_S5K = WS_S5BB + 524288;
constexpr size_t WS_W = 9 * MiB;
constexpr size_t WS_H = 77 * MiB;
constexpr size_t WS_BR = 117 * MiB;
constexpr size_t WS_G = 157 * MiB;
constexpr size_t WS_END = 357 * MiB;
static_assert(WS_S5K + 2097152 <= WS_W, "misc");
constexpr size_t WO_13A = 0, WO_2A = WO_13A + 5632 * 1024, WO_13B = WO_2A + 1024 * 2816, WO_2B = WO_13B + 5632 * 1024,
                 WO_IN = WO_2B + 1024 * 2816, WO_G = WO_IN + 2560 * 1024, WO_BR = WO_G + 4096 * 1024, WO_O = WO_BR + 4 * 1024 * 256,
                 WO_UQ = WO_O + 1024 * 1024, WO_UK = WO_UQ + 384 * 192, WO_UV = WO_UK + 256 * 128, WO_UKC = WO_UV + 256 * 128, WO_UVC = WO_UKC + 256 * 128,
                 WO_GLU = WO_UVC + 256 * 128, WO_S5T = WO_GLU + 256 * 256, WO_S5WS = WO_S5T + 16 * 512 * 512, WO_S5WO = WO_S5WS + 16 * 256 * 512,
                 WO_END = WO_S5WO + 16 * 512 * 256;
static_assert(WO_END * 2 <= 68 * MiB, "weights region");
constexpr size_t GO_PROJ = 0;
constexpr size_t GO_QB = GO_PROJ + (size_t)NTOK * PLD * 2;
constexpr size_t GO_KB = GO_QB + (size_t)NTOK * 384 * 2;
constexpr size_t GO_VT = GO_KB + (size_t)24576 * 384 * 2;
constexpr size_t GO_RKT = GO_VT + (size_t)24576 * 256 * 2;
constexpr size_t GO_RVT = GO_RKT + (size_t)NTOK * 256 * 2;
constexpr size_t GO_RETKV = GO_RVT + (size_t)NTOK * 256 * 2;
constexpr size_t GO_RETSIN = GO_RETKV + (size_t)160 * 8 * 4096 * 4;
constexpr size_t GO_S5LOC = GO_RETSIN + (size_t)160 * 8 * 4096 * 2;
constexpr size_t GO_S5SIN = GO_S5LOC + (size_t)640 * 16 * 256 * 4;
constexpr size_t GO_END = GO_S5SIN + (size_t)640 * 16 * 256 * 2;
static_assert(GO_END <= 200 * MiB, "G region");
static_assert((size_t)NTOK * 4096 * 2 <= 200 * MiB, "gates");
constexpr int CW_BAR = 4096;
constexpr int LDS_BYTES = 147456;

constexpr size_t OUT_S5 = 20971520, OUT_RET = OUT_S5 + 131072, OUT_CACHE = OUT_RET + 1048576;

struct Params { const float* in[36]; float* out; unsigned char* ws; };
__device__ __forceinline__ unsigned long long karg_q(int byte_off) {
    auto ka = __builtin_amdgcn_kernarg_segment_ptr();
    unsigned long long v; asm volatile("s_load_dwordx2 %0, %1, %2\n\ts_waitcnt lgkmcnt(0)" : "=s"(v) : "s"(ka), "s"(byte_off)); return v; }
__device__ __forceinline__ const float* ain(int k) { return (const float*)karg_q(8 * k); }
__device__ __forceinline__ float* aout() { return (float*)karg_q(288); }
__device__ __forceinline__ unsigned char* aws() { return (unsigned char*)karg_q(296); }

__device__ __forceinline__ float bflo(unsigned u) { return __uint_as_float(u << 16); }
__device__ __forceinline__ float bfhi(unsigned u) { return __uint_as_float(u & 0xffff0000u); }
__device__ __forceinline__ float bf1(bf16_t v) { return __uint_as_float(((unsigned)v) << 16); }
__device__ __forceinline__ unsigned f2bf(float f) { unsigned u = __float_as_uint(f); return (u + 0x7fffu + ((u >> 16) & 1u)) >> 16; }
__device__ __forceinline__ unsigned pk2(float lo, float hi) { return f2bf(lo) | (f2bf(hi) << 16); }
__device__ __forceinline__ u32x2 pk4(f32x4 v) { u32x2 r; r.x = pk2(v[0], v[1]); r.y = pk2(v[2], v[3]); return r; }
__device__ __forceinline__ f32x4 up4(u32x2 u) { f32x4 r; r[0] = bflo(u.x); r[1] = bfhi(u.x); r[2] = bflo(u.y); r[3] = bfhi(u.y); return r; }
__device__ __forceinline__ float sigm(float x) { return 1.f / (1.f + __expf(-x)); }
__device__ __forceinline__ float silu(float x) { return x / (1.f + __expf(-x)); }
__device__ __forceinline__ float gelu_t(float x) { const float a = 1.5957691216057308f * (x + 0.044715f * x * x * x); return x / (1.f + __expf(-a)); }
__device__ __forceinline__ float wave_sum(float v) {
#pragma unroll
    for (int o = 1; o < 64; o <<= 1) v += __shfl_xor(v, o);
    return v;
}
__device__ __forceinline__ int tok_seq(int tok) { return tok < NPT ? (tok >> 8) : 16 + ((tok - NPT) >> 11); }
__device__ __forceinline__ int tok_t(int tok) { return tok < NPT ? (tok & 255) : ((tok - NPT) & 2047); }
__device__ __forceinline__ int tok_cond(int tok) { return tok < NPT ? 0 : 1 + ((tok - NPT) >> 11); }
__device__ __forceinline__ int tok_keyrow(int tok) { return tok < NPT ? tok : NPT + ((tok - NPT) >> 11) * 2560 + ((tok - NPT) & 2047); }
__device__ __forceinline__ int seq_len(int s) { return s < 16 ? 256 : 2048; }
__device__ __forceinline__ int seq_start(int s) { return s < 16 ? s * 256 : NPT + (s - 16) * 2048; }
__device__ __forceinline__ int seq_keys(int s) { return s < 16 ? 256 : 2560; }
__device__ __forceinline__ int seq_kbase(int s) { return s < 16 ? s * 256 : NPT + (s - 16) * 2560; }

#define XB_TMO      128
#define XB_XCNT(j)  (256  + 64 * (j))
#define XB_XSUB(j)  (1280 + 64 * (j))
#define XB_XGEN(j)  (2304 + 64 * (j))
#define XB_TOP      3328
#define XB_TOPGEN   3392
#define XCD_BAR_WORDS 3456
#define XB_SPIN_CAP (1u << 22)
__device__ __forceinline__ unsigned xb_ld(unsigned* p)              { return __hip_atomic_load(p, __ATOMIC_RELAXED, __HIP_MEMORY_SCOPE_AGENT); }
__device__ __forceinline__ unsigned xb_add(unsigned* p, unsigned v) { return __hip_atomic_fetch_add(p, v, __ATOMIC_RELAXED, __HIP_MEMORY_SCOPE_AGENT); }
__device__ __forceinline__ unsigned xb_xcc_id() { return (unsigned)__builtin_amdgcn_s_getreg((3 << 11) | 20) & 0xFu; }
#define XB_SPIN(cond, bar) do { unsigned _sp = 0; while (cond) { __builtin_amdgcn_s_sleep(1); \
    if ((++_sp & 255u) == 0u) { if (xb_ld(&(bar)[XB_TMO])) break; if (_sp > XB_SPIN_CAP) { atomicAdd(&(bar)[XB_TMO], 1u); break; } } } } while (0)
struct XcdBarrier { unsigned* bar; unsigned x; volatile LAS unsigned* st; };
__device__ __forceinline__ XcdBarrier xcd_barrier_post(unsigned* bar, volatile LAS unsigned* st) {
    XcdBarrier b; b.bar = bar; b.x = xb_xcc_id(); b.st = st;
    if (threadIdx.x == 0) (void)xb_add(&bar[XB_XCNT(b.x)], 1u);
    return b;
}
__device__ __forceinline__ void xcd_barrier_complete(unsigned* bar, unsigned x, unsigned& nloc, unsigned& nx) {
    const unsigned G = gridDim.x * gridDim.y * gridDim.z;
    unsigned sum, cnt, mine, sp = 0u;
    for (;;) {
        sum = 0u; cnt = 0u; mine = 0u;
#pragma unroll
        for (unsigned j = 0; j < 16; ++j) { const unsigned c = xb_ld(&bar[XB_XCNT(j)]); sum += c; cnt += (c > 0u) ? 1u : 0u; mine = (j == x) ? c : mine; }
        if (sum == G) break;
        __builtin_amdgcn_s_sleep(1);
        if ((++sp & 255u) == 0u) { if (xb_ld(&bar[XB_TMO])) break; if (sp > XB_SPIN_CAP) { atomicAdd(&bar[XB_TMO], 1u); break; } }
    }
    nloc = mine > 0u ? mine : 1u; nx = cnt > 0u ? cnt : 1u;
}
__device__ __forceinline__ void xcd_barrier(const XcdBarrier& b) {
    asm volatile("s_waitcnt vmcnt(0)" ::: "memory");
    __syncthreads();
    if (threadIdx.x == 0) {
        unsigned* bar = b.bar;
        __builtin_amdgcn_s_waitcnt(0);
        unsigned nloc = b.st[0], nx = b.st[1];
        if (nloc == 0u) { xcd_barrier_complete(bar, b.x, nloc, nx); b.st[0] = nloc; b.st[1] = nx; }
        const unsigned old = xb_add(&bar[XB_XSUB(b.x)], 1u);
        const unsigned gen = old / nloc;
        if (old + 1u == (gen + 1u) * nloc) {
            __builtin_amdgcn_fence(__ATOMIC_RELEASE, "agent");
            asm volatile("s_waitcnt vmcnt(0)" ::: "memory");
            const unsigned og = xb_add(&bar[XB_TOP], 1u);
            const unsigned tg = og / nx;
            if (og + 1u == (tg + 1u) * nx) xb_add(&bar[XB_TOPGEN], 1u);
            else XB_SPIN(xb_ld(&bar[XB_TOPGEN]) == tg, bar);
            __builtin_amdgcn_fence(__ATOMIC_ACQUIRE, "agent");
            xb_add(&bar[XB_XGEN(b.x)], 1u);
            asm volatile("s_waitcnt vmcnt(0)" ::: "memory");
        } else {
            XB_SPIN(xb_ld(&bar[XB_XGEN(b.x)]) == gen, bar);
            __builtin_amdgcn_fence(__ATOMIC_ACQUIRE, "agent");
            asm volatile("s_waitcnt vmcnt(0)" ::: "memory");
        }
    }
    __syncthreads();
}

constexpr int G_ROWB = 144, G_ABUF = 128 * G_ROWB, G_LDS = 4 * G_ABUF;
template <bool ROWSSQ, class AF>
__device__ __forceinline__ void gemm_main(LAS unsigned char* lds, f32x4 (&acc)[2][4], float (&ssq)[2], AF aptr, const bf16_t* __restrict__ Bt, int ldb, int K, int m0, int n0, bool swap) {
    int tid_ = threadIdx.x; asm volatile("" : "+v"(tid_));
    const int tid = tid_, lane = tid & 63, wave = tid >> 6, wm = wave >> 1, wn = wave & 1, lr = lane & 15, g = lane >> 4;
    const int nk = K >> 6;
    u32x4 ra[2], rb[2];
    const int lrow0 = tid >> 3, lkc = tid & 7;
    auto gload = [&](int kt) {
#pragma unroll
        for (int i = 0; i < 2; ++i) {
            const int row = lrow0 + 64 * i;
            ra[i] = *(const u32x4*)aptr(m0 + row, kt * 8 + lkc);
            rb[i] = *(const u32x4*)(Bt + (size_t)(n0 + row) * ldb + kt * 64 + lkc * 8);
        }
    };
    auto sstore = [&](int buf) {
#pragma unroll
        for (int i = 0; i < 2; ++i) {
            const int row = lrow0 + 64 * i;
            *(LAS u32x4*)(lds + buf * G_ABUF + row * G_ROWB + lkc * 16) = ra[i];
            *(LAS u32x4*)(lds + (2 + buf) * G_ABUF + row * G_ROWB + lkc * 16) = rb[i];
        }
    };
    gload(0); sstore(0); __syncthreads();
    for (int kt = 0; kt < nk; ++kt) {
        const int buf = kt & 1;
        if (kt + 1 < nk) gload(kt + 1);
#pragma unroll
        for (int ks = 0; ks < 2; ++ks) {
            bf16x8 af[2], bfr[4];
#pragma unroll
            for (int mt = 0; mt < 2; ++mt) af[mt] = *(const LAS bf16x8*)(lds + buf * G_ABUF + (32 * wm + 16 * mt + lr) * G_ROWB + (4 * ks + g) * 16);
#pragma unroll
            for (int nt = 0; nt < 4; ++nt) bfr[nt] = *(const LAS bf16x8*)(lds + (2 + buf) * G_ABUF + (64 * wn + 16 * nt + lr) * G_ROWB + (4 * ks + g) * 16);
            if (ROWSSQ) {
#pragma unroll
                for (int mt = 0; mt < 2; ++mt)
#pragma unroll
                    for (int j = 0; j < 8; ++j) { const float v = bf1((bf16_t)af[mt][j]); ssq[mt] += v * v; }
            }
            if (swap) {
#pragma unroll
                for (int mt = 0; mt < 2; ++mt)
#pragma unroll
                    for (int nt = 0; nt < 4; ++nt) acc[mt][nt] = __builtin_amdgcn_mfma_f32_16x16x32_bf16(af[mt], bfr[nt], acc[mt][nt], 0, 0, 0);
            } else {
#pragma unroll
                for (int mt = 0; mt < 2; ++mt)
#pragma unroll
                    for (int nt = 0; nt < 4; ++nt) acc[mt][nt] = __builtin_amdgcn_mfma_f32_16x16x32_bf16(bfr[nt], af[mt], acc[mt][nt], 0, 0, 0);
            }
        }
        if (kt + 1 < nk) sstore(buf ^ 1);
        __syncthreads();
    }
}
__device__ __forceinline__ void acc_zero(f32x4 (&acc)[2][4]) {
#pragma unroll
    for (int a = 0; a < 2; ++a)
#pragma unroll
        for (int b = 0; b < 4; ++b) acc[a][b] = (f32x4){0.f, 0.f, 0.f, 0.f};
}
__device__ __forceinline__ void ssq_finish(float (&ssq)[2]) {
#pragma unroll
    for (int mt = 0; mt < 2; ++mt) { ssq[mt] += __shfl_xor(ssq[mt], 16); ssq[mt] += __shfl_xor(ssq[mt], 32); }
}
struct APlain { const bf16_t* A; int lda; __device__ __forceinline__ const bf16_t* operator()(int row, int kc) const { return A + (size_t)row * lda + kc * 8; } };
struct AS5U { const bf16_t* proj; int g; __device__ __forceinline__ const bf16_t* operator()(int row, int kc) const { return proj + (size_t)(row * 32 + (kc >> 1)) * PLD + PC_U + 16 * g + 8 * (kc & 1); } };

namespace pg8 {
#define PG8_LAS __attribute__((address_space(3)))
typedef unsigned short bf16_t;
typedef short bf16x8 __attribute__((ext_vector_type(8)));
typedef float f32x4 __attribute__((ext_vector_type(4)));
typedef unsigned u32x4 __attribute__((ext_vector_type(4)));
constexpr int BM = 256, BK = 64, HALF = 128, HTB = HALF * BK * 2  , STAGE_BYTES = 8 * HTB, NXCD = 8, WGM = 8;

__host__ __device__ __forceinline__ int lds_byte(int r, int c) { const int st = (r >> 4) * 2 + (c >> 5), rr = r & 15, cc = c & 31, ob = rr * 64 + cc * 2; return st * 1024 + (ob ^ (((ob >> 9) & 1) << 5)); }
__host__ __device__ __forceinline__ void stage_rc(int b, int& R, int& C) { const int st = b / 1024, sb = b % 1024, swz = sb ^ (((sb >> 9) & 1) << 5); R = (st >> 1) * 16 + swz / 64; C = (st & 1) * 32 + (swz % 64) / 2; }
__host__ __device__ __forceinline__ int perm32(int rho) { const int n = rho >> 4, i = rho & 15; return 8 * (i >> 2) + 4 * n + (i & 3); }

struct Unit { int pm, pn; };
struct Gemm { const bf16_t* A; const bf16_t* Bt; int M, N, K; };

struct StaticOrder {
    int nM, nN, nwg, G, c;
    __host__ __device__ void init(int M, int N, int G_, int c_) { nM = M / BM; nN = N / BM; nwg = nM * nN; G = G_; c = c_; }
    __host__ __device__ bool next(int i, Unit& u) const {
        const long L = (long)i * G + c; if (L >= nwg) return false;
        int wgid = (int)L; { const int q = nwg / NXCD, r = nwg % NXCD, xcd = wgid % NXCD, off = wgid / NXCD; wgid = (xcd < r ? xcd * (q + 1) : r * (q + 1) + (xcd - r) * q) + off; }
        const int nig = WGM * nN, gid = wgid / nig, fm = gid * WGM, gsz = (nM - fm) < WGM ? (nM - fm) : WGM;
        u.pm = fm + ((wgid % nig) % gsz); u.pn = (wgid % nig) / gsz; return true;
    }
    __device__ __forceinline__ void a_ready(const Unit&) const {}
    __device__ __forceinline__ void done(const Unit&) const {}
};

__device__ __forceinline__ unsigned cvt_pk_bf16(float lo, float hi) { unsigned r; asm volatile("v_cvt_pk_bf16_f32 %0, %1, %2" : "=v"(r) : "v"(lo), "v"(hi)); return r; }
template <class Epi, class Sched, bool ALIGN_EPI = false, bool SP2 = false>
__device__ __forceinline__ void gemm_phase(PG8_LAS unsigned char* lds, const Gemm g, const Sched& S, const Epi& E) {
    int tid_ = threadIdx.x; asm volatile("" : "+v"(tid_));
    const int tid = tid_, wid = __builtin_amdgcn_readfirstlane(tid >> 6), lane = tid & 63, wr = wid >> 2, wc = wid & 3, fr = lane & 15, fq = lane >> 4;
    const int K = g.K, nt = K / BK;
    unsigned voffA[2], voffB[2];
#pragma unroll
    for (int i = 0; i < 2; ++i) { int R, C; stage_rc(tid * 16 + i * 8192, R, C); const int Rb = Epi::PERM ? ((R & ~31) + perm32(R & 31)) : R;
        voffA[i] = (unsigned)(R * K + C) * 2u; voffB[i] = (unsigned)(Rb * K + C) * 2u; }
    const size_t kstep = (size_t)(BK * 2);
    const size_t hstep = (size_t)HALF * K * 2;
    const size_t tstep = 2 * hstep;
    const unsigned ldsw = (unsigned)wid * 1024u;
    const int aoff = lds_byte(wr * 64 + fr, fq * 8), boff = lds_byte(wc * 32 + fr, fq * 8);
#define PG8_SA(b, h) (((b) * 2 + (h)) * HTB)
#define PG8_SB(b, h) ((4 + (b) * 2 + (h)) * HTB)
#define PG8_STAGE(bufoff, gbase, voff) do { _Pragma("unroll") for (int _i = 0; _i < 2; ++_i) \
        __builtin_amdgcn_global_load_lds((const unsigned*)((const char*)(gbase) + (voff)[_i]), (PG8_LAS unsigned*)(lds + (bufoff) + ldsw + _i * 8192), 16, 0, 0); } while (0)
#define PG8_LDA(dst, b, h) do { _Pragma("unroll") for (int m = 0; m < 4; ++m) _Pragma("unroll") for (int k = 0; k < 2; ++k) dst[m][k] = *(const PG8_LAS bf16x8*)(lds + PG8_SA(b, h) + aoff + m * 2048 + k * 1024); } while (0)
#define PG8_LDB(dst, b, h) do { _Pragma("unroll") for (int n = 0; n < 2; ++n) _Pragma("unroll") for (int k = 0; k < 2; ++k) dst[n][k] = *(const PG8_LAS bf16x8*)(lds + PG8_SB(b, h) + boff + n * 2048 + k * 1024); } while (0)
#define PG8_MMA(ai, bj, At, Bt) do { __builtin_amdgcn_s_setprio(1); _Pragma("unroll") for (int m = 0; m < 4; ++m) _Pragma("unroll") for (int n = 0; n < 2; ++n) _Pragma("unroll") for (int k = 0; k < 2; ++k) \
        acc[ai][bj][m][n] = __builtin_amdgcn_mfma_f32_16x16x32_bf16(Bt[n][k], At[m][k], acc[ai][bj][m][n], 0, 0, 0); __builtin_amdgcn_s_setprio(0); } while (0)
#define PG8_WAIT_V(n) asm volatile("s_waitcnt vmcnt(" #n ")" ::: "memory")
#define PG8_WAIT_L(n) asm volatile("s_waitcnt lgkmcnt(" #n ")" ::: "memory")
#define PG8_BAR __builtin_amdgcn_s_barrier()
#define PG8_SCHED __builtin_amdgcn_sched_barrier(0)
    Unit cur, nxt; int ui = 0;
    if (!S.next(0, cur)) return;
    f32x4 acc[2][2][4][2];
#pragma unroll
    for (int a = 0; a < 2; ++a)
#pragma unroll
        for (int b = 0; b < 2; ++b)
#pragma unroll
            for (int m = 0; m < 4; ++m)
#pragma unroll
                for (int n = 0; n < 2; ++n) acc[a][b][m][n] = (f32x4){0.f, 0.f, 0.f, 0.f};
    bf16x8 At[4][2], B0[2][2], B1[2][2];
    const char* cA = (const char*)g.A + (size_t)cur.pm * tstep; const char* cB = (const char*)g.Bt + (size_t)cur.pn * tstep;
    S.a_ready(cur);
    if constexpr (SP2) {
        PG8_STAGE(PG8_SB(0, 0), cB, voffB); PG8_STAGE(PG8_SB(0, 1), cB + hstep, voffB); PG8_STAGE(PG8_SA(0, 0), cA, voffA); PG8_STAGE(PG8_SA(0, 1), cA + hstep, voffA);
        if (wr == 1) PG8_BAR;
        PG8_WAIT_V(2); PG8_BAR;
        PG8_STAGE(PG8_SB(1, 0), cB + kstep, voffB); PG8_STAGE(PG8_SA(1, 0), cA + kstep, voffA); PG8_STAGE(PG8_SB(1, 1), cB + hstep + kstep, voffB);
        PG8_WAIT_V(6); PG8_BAR;
    } else {
        PG8_STAGE(PG8_SB(0, 0), cB, voffB); PG8_STAGE(PG8_SA(0, 0), cA, voffA); PG8_STAGE(PG8_SB(0, 1), cB + hstep, voffB); PG8_STAGE(PG8_SA(0, 1), cA + hstep, voffA);
        if (wr == 1) PG8_BAR;
        PG8_WAIT_V(4); PG8_BAR;
        PG8_STAGE(PG8_SB(1, 0), cB + kstep, voffB); PG8_STAGE(PG8_SA(1, 0), cA + kstep, voffA); PG8_STAGE(PG8_SB(1, 1), cB + hstep + kstep, voffB);
        PG8_WAIT_V(6); PG8_BAR;
    }
    for (;;) {
        const bool has_next = S.next(ui + 1, nxt);
        const char* nA = has_next ? (const char*)g.A + (size_t)nxt.pm * tstep : cA; const char* nB = has_next ? (const char*)g.Bt + (size_t)nxt.pn * tstep : cB;
        for (int t = 0; t < nt; t += 2) {
            const bool last = (t == nt - 2);
            const char* a1 = cA + (size_t)(t + 1) * kstep;
            const char* a2 = last ? nA : cA + (size_t)(t + 2) * kstep; const char* b2 = last ? nB : cB + (size_t)(t + 2) * kstep;
            const char* a3 = a2 + kstep; const char* b3 = b2 + kstep;
            if (last && has_next) S.a_ready(nxt);
            if constexpr (SP2) {
            PG8_LDB(B0, 0, 0); PG8_LDB(B1, 0, 1); PG8_SCHED; PG8_LDA(At, 0, 0); PG8_STAGE(PG8_SA(1, 1), a1 + hstep, voffA);
            PG8_WAIT_V(8); PG8_WAIT_L(0); PG8_BAR; PG8_MMA(0, 0, At, B0); PG8_MMA(0, 1, At, B1); PG8_BAR; PG8_SCHED;
            PG8_LDA(At, 0, 1); PG8_STAGE(PG8_SB(0, 0), b2, voffB); PG8_STAGE(PG8_SB(0, 1), b2 + hstep, voffB); PG8_STAGE(PG8_SA(0, 0), a2, voffA);
            PG8_WAIT_V(8); PG8_WAIT_L(0); PG8_BAR; PG8_MMA(1, 0, At, B0); PG8_MMA(1, 1, At, B1); PG8_BAR; PG8_SCHED;
            PG8_LDB(B0, 1, 0); PG8_LDB(B1, 1, 1); PG8_SCHED; PG8_LDA(At, 1, 0); PG8_STAGE(PG8_SA(0, 1), a2 + hstep, voffA);
            PG8_WAIT_V(8); PG8_WAIT_L(0); PG8_BAR; PG8_MMA(0, 0, At, B0); PG8_MMA(0, 1, At, B1); PG8_BAR; PG8_SCHED;
            PG8_LDA(At, 1, 1); PG8_STAGE(PG8_SB(1, 0), b3, voffB); PG8_STAGE(PG8_SB(1, 1), b3 + hstep, voffB); PG8_STAGE(PG8_SA(1, 0), a3, voffA);
            PG8_WAIT_V(8); PG8_WAIT_L(0); PG8_BAR; PG8_MMA(1, 0, At, B0); PG8_MMA(1, 1, At, B1); PG8_BAR; PG8_SCHED;
            } else {
            PG8_LDB(B0, 0, 0); PG8_SCHED; PG8_LDA(At, 0, 0); PG8_STAGE(PG8_SA(1, 1), a1 + hstep, voffA);
            PG8_WAIT_L(8); PG8_BAR; PG8_WAIT_L(0); PG8_MMA(0, 0, At, B0); PG8_BAR; PG8_SCHED;
            PG8_LDB(B1, 0, 1); PG8_STAGE(PG8_SB(0, 0), b2, voffB);
            PG8_BAR; PG8_WAIT_L(0); PG8_MMA(0, 1, At, B1); PG8_BAR;
            PG8_LDA(At, 0, 1); PG8_STAGE(PG8_SA(0, 0), a2, voffA);
            PG8_BAR; PG8_WAIT_L(0); PG8_MMA(1, 0, At, B0); PG8_BAR; PG8_SCHED;
            PG8_STAGE(PG8_SB(0, 1), b2 + hstep, voffB);
            PG8_WAIT_V(6); PG8_BAR; PG8_MMA(1, 1, At, B1); PG8_BAR;
            PG8_LDB(B0, 1, 0); PG8_SCHED; PG8_LDA(At, 1, 0); PG8_STAGE(PG8_SA(0, 1), a2 + hstep, voffA);
            PG8_WAIT_L(8); PG8_BAR; PG8_WAIT_L(0); PG8_MMA(0, 0, At, B0); PG8_BAR; PG8_SCHED;
            PG8_LDB(B1, 1, 1); PG8_STAGE(PG8_SB(1, 0), b3, voffB);
            PG8_BAR; PG8_WAIT_L(0); PG8_MMA(0, 1, At, B1); PG8_BAR;
            PG8_LDA(At, 1, 1); PG8_STAGE(PG8_SA(1, 0), a3, voffA);
            PG8_BAR; PG8_WAIT_L(0); PG8_MMA(1, 0, At, B0); PG8_BAR; PG8_SCHED;
            PG8_STAGE(PG8_SB(1, 1), b3 + hstep, voffB);
            PG8_WAIT_V(6); PG8_BAR; PG8_MMA(1, 1, At, B1); PG8_BAR;
            }
        }
        if constexpr (ALIGN_EPI) { if (wr == 0) PG8_BAR; }
        if constexpr (!Epi::AFTER_DRAIN) { E(acc, cur, wr, wc, fr, fq); S.done(cur); }
        if (!has_next) break;
#pragma unroll
        for (int a = 0; a < 2; ++a)
#pragma unroll
            for (int b = 0; b < 2; ++b)
#pragma unroll
                for (int m = 0; m < 4; ++m)
#pragma unroll
                    for (int n = 0; n < 2; ++n) acc[a][b][m][n] = (f32x4){0.f, 0.f, 0.f, 0.f};
        cur = nxt; cA = nA; cB = nB; ++ui;
        if constexpr (ALIGN_EPI) { if (wr == 1) PG8_BAR; }
    }
    PG8_WAIT_V(0);
    if constexpr (!ALIGN_EPI) { if (wr == 0) PG8_BAR; }
    PG8_BAR;
    if constexpr (Epi::AFTER_DRAIN) { E.fused(acc, cur, wr, wc, fr, fq, lds, wid, lane); S.done(cur); }
#undef PG8_SA
#undef PG8_SB
#undef PG8_STAGE
#undef PG8_LDA
#undef PG8_LDB
#undef PG8_MMA
#undef PG8_WAIT_V
#undef PG8_WAIT_L
#undef PG8_BAR
#undef PG8_SCHED
}
}

struct EpiUp {
    static constexpr bool PERM = true, AFTER_DRAIN = false; bf16_t* hid;
    __device__ __forceinline__ void operator()(const f32x4 (&acc)[2][2][4][2], const pg8::Unit& u, int wr, int wc, int fr, int fq) const {
        const int row0 = u.pm * 256 + wr * 64 + fr, col0 = u.pn * 128 + wc * 32 + 8 * fq;
#pragma unroll
        for (int ai = 0; ai < 2; ++ai)
#pragma unroll
            for (int m = 0; m < 4; ++m) { f32x4 v0, v1;
#pragma unroll
                for (int r = 0; r < 4; ++r) { v0[r] = silu(acc[ai][0][m][0][r]) * acc[ai][1][m][0][r]; v1[r] = silu(acc[ai][0][m][1][r]) * acc[ai][1][m][1][r]; }
                u32x4 w; w.x = pk2(v0[0], v0[1]); w.y = pk2(v0[2], v0[3]); w.z = pk2(v1[0], v1[1]); w.w = pk2(v1[2], v1[3]);
                *(u32x4*)(hid + (size_t)(row0 + ai * 128 + m * 16) * FF + col0) = w; }
    }
};
template <bool GATE> struct EpiB16 {
    static constexpr bool PERM = true, AFTER_DRAIN = false; bf16_t* O; int ldc; const float* bias;
    __device__ __forceinline__ void operator()(const f32x4 (&acc)[2][2][4][2], const pg8::Unit& u, int wr, int wc, int fr, int fq) const {
        const int row0 = u.pm * 256 + wr * 64 + fr, col0 = u.pn * 256 + wc * 32 + 8 * fq;
        f32x4 bv[2][2];
#pragma unroll
        for (int bj = 0; bj < 2; ++bj)
#pragma unroll
            for (int n = 0; n < 2; ++n) bv[bj][n] = GATE ? *(const f32x4*)(bias + col0 + bj * 128 + 4 * n) : (f32x4){0.f, 0.f, 0.f, 0.f};
#pragma unroll
        for (int ai = 0; ai < 2; ++ai)
#pragma unroll
            for (int m = 0; m < 4; ++m)
#pragma unroll
                for (int bj = 0; bj < 2; ++bj) { f32x4 v0 = acc[ai][bj][m][0], v1 = acc[ai][bj][m][1];
                    if (GATE) {
#pragma unroll
                        for (int r = 0; r < 4; ++r) { v0[r] = sigm(v0[r] + bv[bj][0][r]); v1[r] = sigm(v1[r] + bv[bj][1][r]); } }
                    u32x4 w; w.x = pk2(v0[0], v0[1]); w.y = pk2(v0[2], v0[3]); w.z = pk2(v1[0], v1[1]); w.w = pk2(v1[2], v1[3]);
                    *(u32x4*)(O + (size_t)(row0 + ai * 128 + m * 16) * ldc + col0 + bj * 128) = w; }
    }
};
struct EpiWin {
    static constexpr bool PERM = false, AFTER_DRAIN = false;
    bf16_t* proj; bf16_t* rkT; bf16_t* rvT; const float* rope;
    __device__ __forceinline__ void operator()(const f32x4 (&acc)[2][2][4][2], const pg8::Unit& u, int wr, int wc, int fr, int fq) const {
        const float* rRc = rope; const float* rRs = rope + 65536; const float* rMc = rope + 131072; const float* rMs = rMc + 32768;
        const int wq = wc & 1;
#pragma unroll
        for (int bj = 0; bj < 2; ++bj) {
            const int hb = u.pn * 256 + bj * 128 + 64 * (wc >> 1);
#pragma unroll
            for (int ai = 0; ai < 2; ++ai)
#pragma unroll
                for (int m = 0; m < 4; ++m) {
                    const int tok = u.pm * 256 + ai * 128 + wr * 64 + m * 16 + fr; const bool samp = tok >= NPT; const int t = tok_t(tok);
                    f32x4 x1 = acc[ai][bj][m][0], x2 = acc[ai][bj][m][1];
                    if (hb >= 256 && hb < 768) {
                        const int dA = 16 * wq + 4 * fq;
                        if (samp) { const f32x4 c = *(const f32x4*)(rRc + t * 32 + dA), s = *(const f32x4*)(rRs + t * 32 + dA);
                            const f32x4 y1 = x1 * c - x2 * s, y2 = x1 * s + x2 * c; x1 = y1; x2 = y2; }
                        if (hb < 512) { *(u32x2*)(proj + (size_t)tok * PLD + hb + dA) = pk4(x1); *(u32x2*)(proj + (size_t)tok * PLD + hb + 32 + dA) = pk4(x2); }
                        else { x1 = x1 * 0.125f; x2 = x2 * 0.125f; const int head = (hb - 512) >> 6;
                            *(u32x2*)(proj + (size_t)tok * PLD + hb + dA) = pk4(x1); *(u32x2*)(proj + (size_t)tok * PLD + hb + 32 + dA) = pk4(x2);
                            bf16_t* kt = rkT + (((size_t)(tok >> 7) * 4 + head) * 64 + dA) * 128 + (tok & 127);
#pragma unroll
                            for (int r = 0; r < 4; ++r) { kt[(size_t)r * 128] = (bf16_t)f2bf(x1[r]); kt[(size_t)(32 + r) * 128] = (bf16_t)f2bf(x2[r]); } }
                    } else if (hb >= 768 && hb < 1024) {
                        const int head = (hb - 768) >> 6; bf16_t* vt = rvT + (((size_t)(tok >> 7) * 4 + head) * 64 + 32 * wq + 4 * fq) * 128 + (tok & 127);
#pragma unroll
                        for (int r = 0; r < 4; ++r) { vt[(size_t)r * 128] = (bf16_t)f2bf(x1[r]); vt[(size_t)(16 + r) * 128] = (bf16_t)f2bf(x2[r]); }
                    } else {
                        const int p0 = hb + 32 * wq + 4 * fq;
                        if (p0 == 2368 + 4 * fq && samp) { const f32x4 c = *(const f32x4*)(rMc + t * 16 + 4 * fq), s = *(const f32x4*)(rMs + t * 16 + 4 * fq);
                            const f32x4 y1 = x1 * c - x2 * s, y2 = x1 * s + x2 * c; x1 = y1; x2 = y2; }
                        const int o0 = p0 < 768 ? p0 : p0 - 256;
                        if (p0 < 2400) *(u32x2*)(proj + (size_t)tok * PLD + o0) = pk4(x1);
                        if (p0 + 16 < 2400) *(u32x2*)(proj + (size_t)tok * PLD + o0 + 16) = pk4(x2);
                    }
                }
        }
    }
};

struct Frame {
    LAS unsigned char* lds;
    int tid, lane, wave, bid, G;
    int gw, NGW, gt, NGT;
};
extern __shared__ __attribute__((aligned(16))) unsigned char lds_raw[];
__device__ __forceinline__ Frame mkframe() {
    Frame F; int tid = threadIdx.x, bid = blockIdx.x, G = gridDim.x;
    asm volatile("" : "+v"(tid)); asm volatile("" : "+s"(bid), "+s"(G));
    F.lds = (LAS unsigned char*)lds_raw;
    F.tid = tid; F.lane = tid & 63; F.wave = __builtin_amdgcn_readfirstlane(tid >> 6); F.bid = bid; F.G = G;
    F.gw = F.bid * NWAVES + F.wave; F.NGW = F.G * NWAVES; F.gt = F.bid * NTHR + F.tid; F.NGT = F.G * NTHR;
    return F;
}

__device__ __forceinline__ void ph_mod() {
    const Frame F = mkframe(); unsigned char* const WS = aws(); float* const OUTP = aout(); (void)WS; (void)OUTP;
    LAS float* sc = (LAS float*)F.lds;
    LAS float* part = (LAS float*)(F.lds + 36864);
    float* mod = (float*)(WS + WS_MOD);
    bool loaded = false;
    for (int it = F.bid; it < 288; it += F.G) {
        if (!loaded) {
            for (int i = F.tid; i < 9 * 1024; i += NTHR) { const int r = i >> 10, k = i & 1023; const float c = r == 0 ? ain(6)[k] : ain(5)[(r - 1) * 1024 + k]; sc[i] = silu(c); }
            loaded = true;
        }
        __syncthreads();
        const int l = it / 144, n0 = (it % 144) * 64;
        const float* W = ain(7) + (size_t)l * 1024 * 9216 + n0 + F.lane;
        float a[9];
#pragma unroll
        for (int r = 0; r < 9; ++r) a[r] = 0.f;
        const int k0 = F.wave * 128;
#pragma unroll 8
        for (int k = 0; k < 128; ++k) {
            const float w = W[(size_t)(k0 + k) * 9216];
#pragma unroll
            for (int r = 0; r < 9; ++r) a[r] += sc[r * 1024 + k0 + k] * w;
        }
#pragma unroll
        for (int r = 0; r < 9; ++r) part[(F.wave * 9 + r) * 64 + F.lane] = a[r];
        __syncthreads();
        for (int i = F.tid; i < 576; i += NTHR) {
            const int r = i >> 6, c = i & 63; float s = 0.f;
#pragma unroll
            for (int w = 0; w < 8; ++w) s += part[(w * 9 + r) * 64 + c];
            mod[((size_t)l * 9 + r) * 9216 + n0 + c] = s + ain(8)[(size_t)l * 9216 + n0 + c];
        }
    }
    __syncthreads();
}

__device__ __forceinline__ void ph_tables() {
    const Frame F = mkframe(); unsigned char* const WS = aws(); float* const OUTP = aout(); (void)WS; (void)OUTP;
    float* rr = (float*)(WS + WS_ROPE);
    for (int i = F.gt; i < 2048 * 32; i += F.NGT) {
        const int t = i >> 5, k = i & 31; const float pos = (float)(k < 16 ? (t >> 6) : (t & 63));
        const float inv = powf(10000.0f, -(float)(k & 15) / 16.0f); const float ang = pos * inv;
        rr[i] = cosf(ang); rr[65536 + i] = sinf(ang);
    }
    for (int i = F.gt; i < 2048 * 16; i += F.NGT) {
        const int t = i >> 4, k = i & 15; const float pos = (float)(k < 8 ? (t >> 6) : (t & 63));
        const float inv = powf(10000.0f, -(float)(k & 7) / 8.0f); const float ang = pos * inv;
        rr[131072 + i] = cosf(ang); rr[131072 + 32768 + i] = sinf(ang);
    }
    bf16_t* ca = (bf16_t*)(WS + WS_CTXA);
    for (int i = F.gt; i < 2 * 4096 * 32; i += F.NGT) {
        const int c4 = i & 31, row = (i >> 5) & 4095, l = i >> 17, b = row >> 9, j = row & 511;
        const f32x4 v = *(const f32x4*)(ain(4) + ((size_t)(b * 2 + l) * 512 + j) * 160 + c4 * 4);
        *(u32x2*)(ca + ((size_t)l * 4096 + row) * 128 + c4 * 4) = pk4(v);
    }
    float* pw = (float*)(WS + WS_S5PW); float* bb = (float*)(WS + WS_S5BB);
    for (int ch = F.gt; ch < 4096; ch += F.NGT) {
        const int ldg = ch >> 6;
        const float lre = ain(15)[ch], lim = ain(16)[ch], dt = expf(ain(17)[ldg]);
        float abr = 0.f, abi = 0.f;
        for (int e = 0; e <= 32; ++e) {
            const float mag = expf(lre * dt * (float)e), ang = lim * dt * (float)e;
            const float cr = mag * cosf(ang), ci = mag * sinf(ang);
            pw[((size_t)ch * 33 + e) * 2] = cr; pw[((size_t)ch * 33 + e) * 2 + 1] = ci;
            if (e == 1) { abr = cr; abi = ci; }
        }
        const float den = lre * lre + lim * lim;
        const float fre = ((abr - 1.0f) * lre + abi * lim) / den, fim = (abi * lre - (abr - 1.0f) * lim) / den;
        for (int h = 0; h < 16; ++h) {
            const float br = ain(18)[(size_t)ch * 16 + h], bi = ain(19)[(size_t)ch * 16 + h];
            bb[((size_t)ch * 16 + h) * 2] = fre * br - fim * bi; bb[((size_t)ch * 16 + h) * 2 + 1] = fre * bi + fim * br;
        }
    }
}

__device__ __forceinline__ void ph_s5k() {
    const Frame F = mkframe(); unsigned char* const WS = aws(); float* const OUTP = aout(); (void)WS; (void)OUTP;
    const float* pw = (const float*)(WS + WS_S5PW); const float* bb = (const float*)(WS + WS_S5BB); float* Kd = (float*)(WS + WS_S5K);
    for (int i = F.gt; i < 2 * 2 * 16 * 32 * 256; i += F.NGT) {
        const int hp = i & 15, h = (i >> 4) & 15, dl = (i >> 8) & 31, g = (i >> 13) & 15, d = (i >> 17) & 1, l = i >> 18;
        const float* cr = ain(20) + ((size_t)(l * 16 + g) * 16 + h) * 64; const float* ci = ain(21) + ((size_t)(l * 16 + g) * 16 + h) * 64;
        const size_t ch0 = ((size_t)(l * 2 + d) * 16 + g) * 64;
        float s = 0.f;
        for (int q = 0; q < 64; ++q) {
            const float pr = pw[((ch0 + q) * 33 + dl) * 2], pi = pw[((ch0 + q) * 33 + dl) * 2 + 1];
            const float br = bb[((ch0 + q) * 16 + hp) * 2], bi = bb[((ch0 + q) * 16 + hp) * 2 + 1];
            const float wr = pr * br - pi * bi, wi = pr * bi + pi * br;
            s += cr[q] * wr - ci[q] * wi;
        }
        Kd[i] = s;
    }
}

__device__ __forceinline__ void ph_s5mat(int l) {
    const Frame F = mkframe(); unsigned char* const WS = aws(); float* const OUTP = aout(); (void)WS; (void)OUTP;
    const float* pw = (const float*)(WS + WS_S5PW); const float* bb = (const float*)(WS + WS_S5BB); const float* Kd = (const float*)(WS + WS_S5K);
    bf16_t* Wb = (bf16_t*)(WS + WS_W);
    for (int i = F.gt; i < 16 * 512 * 64; i += F.NGT) {
        const int k8 = i & 63, n = (i >> 6) & 511, g = i >> 15, t = n >> 4, h = n & 15, tau = k8 >> 1, h0 = (k8 & 1) * 8;
        float v[8];
#pragma unroll
        for (int j = 0; j < 8; ++j) v[j] = 0.f;
        if (t >= tau) { const float* s = Kd + ((((size_t)(l * 2 + 0) * 16 + g) * 32 + (t - tau)) * 16 + h) * 16 + h0;
#pragma unroll
            for (int j = 0; j < 8; ++j) v[j] += s[j]; }
        if (tau >= t) { const float* s = Kd + ((((size_t)(l * 2 + 1) * 16 + g) * 32 + (tau - t)) * 16 + h) * 16 + h0;
#pragma unroll
            for (int j = 0; j < 8; ++j) v[j] += s[j]; }
        if (t == tau) { const float dsk = ain(22)[l * 256 + 16 * g + h];
#pragma unroll
            for (int j = 0; j < 8; ++j) if (h0 + j == h) v[j] += dsk; }
        u32x4 o; o.x = pk2(v[0], v[1]); o.y = pk2(v[2], v[3]); o.z = pk2(v[4], v[5]); o.w = pk2(v[6], v[7]);
        *(u32x4*)(Wb + WO_S5T + ((size_t)g * 512 + n) * 512 + k8 * 8) = o;
    }
    for (int i = F.gt; i < 16 * 256 * 64; i += F.NGT) {
        const int k8 = i & 63, n = (i >> 6) & 255, g = i >> 14, d = n >> 7, ri = (n >> 6) & 1, q = n & 63, tau = k8 >> 1, h0 = (k8 & 1) * 8;
        const size_t ch = ((size_t)(l * 2 + d) * 16 + g) * 64 + q; const int e = d == 0 ? 31 - tau : tau;
        const float pr = pw[(ch * 33 + e) * 2], pi = pw[(ch * 33 + e) * 2 + 1];
        float v[8];
#pragma unroll
        for (int j = 0; j < 8; ++j) { const float br = bb[(ch * 16 + h0 + j) * 2], bi = bb[(ch * 16 + h0 + j) * 2 + 1]; v[j] = ri == 0 ? pr * br - pi * bi : pr * bi + pi * br; }
        u32x4 o; o.x = pk2(v[0], v[1]); o.y = pk2(v[2], v[3]); o.z = pk2(v[4], v[5]); o.w = pk2(v[6], v[7]);
        *(u32x4*)(Wb + WO_S5WS + ((size_t)g * 256 + n) * 512 + k8 * 8) = o;
    }
    for (int i = F.gt; i < 16 * 512 * 32; i += F.NGT) {
        const int k8 = i & 31, n = (i >> 5) & 511, g = i >> 14, t = n >> 4, h = n & 15, d = k8 >> 4, ri = (k8 >> 3) & 1, q0 = (k8 & 7) * 8;
        const int e = d == 0 ? t + 1 : 32 - t;
        const float* cr = ain(20) + ((size_t)(l * 16 + g) * 16 + h) * 64 + q0; const float* ci = ain(21) + ((size_t)(l * 16 + g) * 16 + h) * 64 + q0;
        float v[8];
#pragma unroll
        for (int j = 0; j < 8; ++j) { const size_t ch = ((size_t)(l * 2 + d) * 16 + g) * 64 + q0 + j; const float pr = pw[(ch * 33 + e) * 2], pi = pw[(ch * 33 + e) * 2 + 1];
            v[j] = ri == 0 ? cr[j] * pr - ci[j] * pi : -(cr[j] * pi + ci[j] * pr); }
        u32x4 o; o.x = pk2(v[0], v[1]); o.y = pk2(v[2], v[3]); o.z = pk2(v[4], v[5]); o.w = pk2(v[6], v[7]);
        *(u32x4*)(Wb + WO_S5WO + ((size_t)g * 512 + n) * 256 + k8 * 8) = o;
    }
}

template <class DF>
__device__ __forceinline__ void tr_item(const float* __restrict__ W, int K, int N, bf16_t* WT, int ldk, const float* kscale, DF dest, LAS float* scr, int item, int lane) {
    const int nblk = N >> 5, kb = item / nblk, nb = item - kb * nblk, k0 = 64 * kb, n0 = 32 * nb;
#pragma unroll 8
    for (int i = 0; i < 32; ++i) { const int kk = 2 * i + (lane >> 5); float v = W[(size_t)(k0 + kk) * N + n0 + (lane & 31)]; if (kscale) v *= kscale[k0 + kk]; scr[kk * 33 + (lane & 31)] = v; }
    asm volatile("s_waitcnt lgkmcnt(0)" ::: "memory");
    const int c = lane & 7;
#pragma unroll
    for (int j = 0; j < 4; ++j) { const int n = (lane >> 3) + 8 * j; const LAS float* s = scr + (8 * c) * 33 + n;
        u32x4 o; o.x = pk2(s[0 * 33], s[1 * 33]); o.y = pk2(s[2 * 33], s[3 * 33]); o.z = pk2(s[4 * 33], s[5 * 33]); o.w = pk2(s[6 * 33], s[7 * 33]);
        *(u32x4*)(WT + (size_t)dest(n0 + n) * ldk + k0 + 8 * c) = o; }
    asm volatile("s_waitcnt lgkmcnt(0)" ::: "memory");
}
__device__ __forceinline__ void ph_wprep(int l) {
    const Frame F = mkframe(); unsigned char* const WS = aws(); float* const OUTP = aout(); (void)WS; (void)OUTP;
    LAS float* scr = (LAS float*)(F.lds + F.wave * 8448);
    bf16_t* Wb = (bf16_t*)(WS + WS_W);
    auto ident = [](int n) { return n; };
    auto dw1 = [](int j) { return 256 * (j >> 7) + (j & 127); };
    auto dw3 = [](int j) { return 256 * (j >> 7) + 128 + (j & 127); };
    auto dwin = [](int c) { if (c < 256 || c >= 768) return c; const int d = c & 63; return (c & ~63) + 32 * ((d >> 4) & 1) + 16 * (d >> 5) + (d & 15); };
    auto dkv = [](int c) { const int h = c >> 7, w = c & 127; return (w < 64 ? 0 : 256) + h * 64 + (w & 63); };
    constexpr int I_UP = 16 * 88, I_DN = 44 * 32, I_IN = 16 * 75, I_G = 16 * 128, I_BR = 4 * 32, I_O = 16 * 32, I_UQ = 3 * 12, I_KV = 2 * 16, I_GLU = 4 * 8;
    constexpr int NIT = 4 * I_UP + 2 * I_DN + I_IN + I_G + 4 * I_BR + I_O + I_UQ + 2 * I_KV + I_GLU;
    for (int it = F.gw; it < NIT; it += F.NGW) {
        int r = it;
        if (r < 4 * I_UP) { const int which = r / I_UP, f = which >> 1, w3 = which & 1; r -= which * I_UP;
            const float* W = ain(w3 ? 12 : 11) + (size_t)(l * 2 + f) * 1024 * FF; bf16_t* O = Wb + (f ? WO_13B : WO_13A);
            if (w3) tr_item(W, 1024, FF, O, 1024, nullptr, dw3, scr, r, F.lane); else tr_item(W, 1024, FF, O, 1024, nullptr, dw1, scr, r, F.lane);
            continue; }
        r -= 4 * I_UP;
        if (r < 2 * I_DN) { const int f = r / I_DN; r -= f * I_DN; tr_item(ain(13) + (size_t)(l * 2 + f) * FF * 1024, FF, 1024, Wb + (f ? WO_2B : WO_2A), FF, nullptr, ident, scr, r, F.lane); continue; }
        r -= 2 * I_DN;
        if (r < I_IN) { tr_item(ain(14) + (size_t)l * 1024 * 2400, 1024, 2400, Wb + WO_IN, 1024, nullptr, dwin, scr, r, F.lane); continue; }
        r -= I_IN;
        if (r < I_G) { tr_item(ain(33) + (size_t)l * 1024 * 4096, 1024, 4096, Wb + WO_G, 1024, nullptr, ident, scr, r, F.lane); continue; }
        r -= I_G;
        if (r < 4 * I_BR) { const int n = r / I_BR; r -= n * I_BR; tr_item(ain(32) + (size_t)(l * 4 + n) * 256 * 1024, 256, 1024, Wb + WO_BR + (size_t)n * 1024 * 256, 256, nullptr, ident, scr, r, F.lane); continue; }
        r -= 4 * I_BR;
        if (r < I_O) { tr_item(ain(35) + (size_t)l * 1024 * 1024, 1024, 1024, Wb + WO_O, 1024, nullptr, ident, scr, r, F.lane); continue; }
        r -= I_O;
        if (r < I_UQ) { tr_item(ain(29) + (size_t)l * 192 * 384, 192, 384, Wb + WO_UQ, 192, ain(28) + l * 192, ident, scr, r, F.lane); continue; }
        r -= I_UQ;
        if (r < I_KV) { tr_item(ain(31) + (size_t)l * 128 * 512, 128, 512, Wb + WO_UK, 128, ain(30) + l * 128, dkv, scr, r, F.lane); continue; }
        r -= I_KV;
        if (r < I_KV) { tr_item(ain(31) + (size_t)l * 128 * 512, 128, 512, Wb + WO_UKC, 128, nullptr, dkv, scr, r, F.lane); continue; }
        r -= I_KV;
        tr_item(ain(23) + (size_t)l * 256 * 256, 256, 256, Wb + WO_GLU, 256, nullptr, ident, scr, r, F.lane);
    }
}

template <bool FIRST, bool HAS_F, bool HAS_H>
__device__ __forceinline__ void ph_rowpass(const bf16_t* fbuf, const float* npost, const float* modl_g, int gi, float gs,
                                           const float* npre, const float* modl_h, int shi, int sci) {
    const Frame F = mkframe(); unsigned char* const WS = aws(); float* const OUTP = aout(); (void)WS; (void)OUTP;
    bf16_t* Hb = (bf16_t*)(WS + WS_H);
    for (int row = F.gw; row < NTOK; row += F.NGW) {
        const int r = tok_cond(row);
        const float* xr = FIRST ? (row < NPT ? ain(0) + (size_t)row * D : ain(1) + (size_t)(row - NPT) * D) : OUTP + (size_t)row * D;
        f32x4 x[4];
#pragma unroll
        for (int j = 0; j < 4; ++j) x[j] = *(const f32x4*)(xr + 4 * F.lane + 256 * j);
        if (HAS_F) {
            f32x4 fv[4]; float s = 0.f;
#pragma unroll
            for (int j = 0; j < 4; ++j) { fv[j] = up4(*(const u32x2*)(fbuf + (size_t)row * D + 4 * F.lane + 256 * j)); s += fv[j][0] * fv[j][0] + fv[j][1] * fv[j][1] + fv[j][2] * fv[j][2] + fv[j][3] * fv[j][3]; }
            const float rstd = rsqrtf(wave_sum(s) * (1.0f / D) + EPS);
#pragma unroll
            for (int j = 0; j < 4; ++j) {
                const f32x4 np = *(const f32x4*)(npost + 4 * F.lane + 256 * j);
                const f32x4 gg = *(const f32x4*)(modl_g + (size_t)r * 9216 + gi * 1024 + 4 * F.lane + 256 * j);
                x[j] = x[j] + gs * gg * (fv[j] * rstd * np);
                *(f32x4*)(OUTP + (size_t)row * D + 4 * F.lane + 256 * j) = x[j];
            }
        }
        if (HAS_H) {
            float s = 0.f;
#pragma unroll
            for (int j = 0; j < 4; ++j) s += x[j][0] * x[j][0] + x[j][1] * x[j][1] + x[j][2] * x[j][2] + x[j][3] * x[j][3];
            const float rstd = rsqrtf(wave_sum(s) * (1.0f / D) + EPS);
#pragma unroll
            for (int j = 0; j < 4; ++j) {
                const f32x4 np = *(const f32x4*)(npre + 4 * F.lane + 256 * j);
                const f32x4 sc = *(const f32x4*)(modl_h + (size_t)r * 9216 + sci * 1024 + 4 * F.lane + 256 * j);
                const f32x4 sh = *(const f32x4*)(modl_h + (size_t)r * 9216 + shi * 1024 + 4 * F.lane + 256 * j);
                const f32x4 h = (x[j] * rstd * np) * (1.0f + sc) + sh;
                *(u32x2*)(Hb + (size_t)row * D + 4 * F.lane + 256 * j) = pk4(h);
            }
        }
    }
}

__device__ __forceinline__ void ph_ffn_up(int f) {
    const Frame F = mkframe(); unsigned char* const WS = aws(); float* const OUTP = aout(); (void)WS; (void)OUTP;
    const bf16_t* Hb = (const bf16_t*)(WS + WS_H); const bf16_t* Bt = (const bf16_t*)(WS + WS_W) + (f ? WO_13B : WO_13A);
    bf16_t* hid = (bf16_t*)(WS + WS_G);
    const int lr = F.lane & 15, g = F.lane >> 4, wm = F.wave >> 1, wn = F.wave & 1;
    for (int it = F.bid; it < 160 * 44; it += F.G) {
        const int mtile = it / 44, ntile = it - mtile * 44, m0 = mtile * 128, n0 = ntile * 128;
        f32x4 acc[2][4]; float ssq[2] = {0.f, 0.f}; acc_zero(acc);
        gemm_main<false>(F.lds, acc, ssq, APlain{Hb, D}, Bt, D, D, m0, n0, false);
        const int grp = (n0 + 64 * wn) >> 6;
#pragma unroll
        for (int mt = 0; mt < 2; ++mt) { const int row = m0 + 32 * wm + 16 * mt + lr;
#pragma unroll
            for (int nt = 0; nt < 2; ++nt) { f32x4 v;
#pragma unroll
                for (int r = 0; r < 4; ++r) v[r] = silu(acc[mt][nt][r]) * acc[mt][nt + 2][r];
                *(u32x2*)(hid + (size_t)row * FF + 32 * grp + 16 * nt + 4 * g) = pk4(v); } }
    }
}
__device__ __forceinline__ void ph_gemm_n1024(const bf16_t* A, int K, const bf16_t* Bt, bf16_t* O) {
    const Frame F = mkframe(); unsigned char* const WS = aws(); float* const OUTP = aout(); (void)WS; (void)OUTP;
    const int lr = F.lane & 15, g = F.lane >> 4, wm = F.wave >> 1, wn = F.wave & 1;
    for (int it = F.bid; it < 160 * 8; it += F.G) {
        const int mtile = it >> 3, ntile = it & 7, m0 = mtile * 128, n0 = ntile * 128;
        f32x4 acc[2][4]; float ssq[2] = {0.f, 0.f}; acc_zero(acc);
        gemm_main<false>(F.lds, acc, ssq, APlain{A, K}, Bt, K, K, m0, n0, false);
#pragma unroll
        for (int mt = 0; mt < 2; ++mt) { const int row = m0 + 32 * wm + 16 * mt + lr;
#pragma unroll
            for (int nt = 0; nt < 4; ++nt) *(u32x2*)(O + (size_t)row * D + n0 + 64 * wn + 16 * nt + 4 * g) = pk4(acc[mt][nt]); }
    }
}
__device__ __forceinline__ void ph_win() {
    const Frame F = mkframe(); unsigned char* const WS = aws(); float* const OUTP = aout(); (void)WS; (void)OUTP;
    const bf16_t* Hb = (const bf16_t*)(WS + WS_H); const bf16_t* Bt = (const bf16_t*)(WS + WS_W) + WO_IN;
    bf16_t* proj = (bf16_t*)(WS + WS_G + GO_PROJ); bf16_t* rkT = (bf16_t*)(WS + WS_G + GO_RKT); bf16_t* rvT = (bf16_t*)(WS + WS_G + GO_RVT);
    const float* rRc = (const float*)(WS + WS_ROPE); const float* rRs = rRc + 65536; const float* rMc = rRc + 131072; const float* rMs = rMc + 32768;
    const int lr = F.lane & 15, g = F.lane >> 4, wm = F.wave >> 1, wn = F.wave & 1;
    for (int it = F.bid; it < 160 * 20; it += F.G) {
        const int mtile = it / 20, ntile = it - mtile * 20, m0 = mtile * 128, n0 = ntile * 128;
        const bool swap = (n0 >= 512 && n0 < 1024);
        f32x4 acc[2][4]; float ssq[2] = {0.f, 0.f}; acc_zero(acc);
        gemm_main<false>(F.lds, acc, ssq, APlain{Hb, D}, Bt, D, D, m0, n0, swap);
        const int cb = n0 + 64 * wn; const bool samp = m0 >= NPT;
        if (!swap) {
#pragma unroll
            for (int mt = 0; mt < 2; ++mt) {
                const int tok = m0 + 32 * wm + 16 * mt + lr, t = tok_t(tok);
                if (samp && cb >= 256 && cb < 512) {
#pragma unroll
                    for (int nt = 0; nt < 2; ++nt) { const f32x4 c = *(const f32x4*)(rRc + t * 32 + 16 * nt + 4 * g), s = *(const f32x4*)(rRs + t * 32 + 16 * nt + 4 * g);
                        const f32x4 x1 = acc[mt][nt], x2 = acc[mt][nt + 2]; acc[mt][nt] = x1 * c - x2 * s; acc[mt][nt + 2] = x1 * s + x2 * c; }
                }
                if (samp && cb == 2368) {
                    const f32x4 c = *(const f32x4*)(rMc + t * 16 + 4 * g), s = *(const f32x4*)(rMs + t * 16 + 4 * g);
                    const f32x4 x1 = acc[mt][0], x2 = acc[mt][1]; acc[mt][0] = x1 * c - x2 * s; acc[mt][1] = x1 * s + x2 * c;
                }
#pragma unroll
                for (int nt = 0; nt < 4; ++nt) { const int pc = cb + 16 * nt + 4 * g; if (pc >= 2400) continue;
                    const int oc = pc < 768 ? pc : pc - 256; *(u32x2*)(proj + (size_t)tok * PLD + oc) = pk4(acc[mt][nt]); }
            }
        } else if (cb < 768) {
            const int head = (cb - 512) >> 6;
#pragma unroll
            for (int mt = 0; mt < 2; ++mt) {
                const int tok0 = m0 + 32 * wm + 16 * mt + 4 * g, t0 = tok_t(tok0);
                if (samp) {
#pragma unroll
                    for (int nt = 0; nt < 2; ++nt)
#pragma unroll
                        for (int r = 0; r < 4; ++r) { const float c = rRc[(t0 + r) * 32 + 16 * nt + lr], s = rRs[(t0 + r) * 32 + 16 * nt + lr];
                            const float x1 = acc[mt][nt][r], x2 = acc[mt][nt + 2][r]; acc[mt][nt][r] = x1 * c - x2 * s; acc[mt][nt + 2][r] = x1 * s + x2 * c; }
                }
#pragma unroll
                for (int nt = 0; nt < 4; ++nt) { const int dk = 16 * nt + lr; const f32x4 v = acc[mt][nt] * 0.125f;
#pragma unroll
                    for (int r = 0; r < 4; ++r) proj[(size_t)(tok0 + r) * PLD + PC_RK + head * 64 + dk] = (bf16_t)f2bf(v[r]);
                    *(u32x2*)(rkT + (((size_t)(tok0 >> 7) * 4 + head) * 64 + dk) * 128 + (tok0 & 127)) = pk4(v); }
            }
        } else {
            const int head = (cb - 768) >> 6;
#pragma unroll
            for (int mt = 0; mt < 2; ++mt) { const int tok0 = m0 + 32 * wm + 16 * mt + 4 * g;
#pragma unroll
                for (int nt = 0; nt < 4; ++nt) { const int dv = 16 * nt + lr;
                    *(u32x2*)(rvT + (((size_t)(tok0 >> 7) * 4 + head) * 64 + dv) * 128 + (tok0 & 127)) = pk4(acc[mt][nt]); } }
        }
    }
}
__device__ __forceinline__ void ph_gate(int l) {
    const Frame F = mkframe(); unsigned char* const WS = aws(); float* const OUTP = aout(); (void)WS; (void)OUTP;
    const bf16_t* Hb = (const bf16_t*)(WS + WS_H); const bf16_t* Wb = (const bf16_t*)(WS + WS_W);
    bf16_t* gates = (bf16_t*)(WS + WS_G); bf16_t* br = (bf16_t*)(WS + WS_BR);
    const bf16_t* zb = (const bf16_t*)(WS + WS_G + GO_S5LOC);
    const int lr = F.lane & 15, g = F.lane >> 4, wm = F.wave >> 1, wn = F.wave & 1;
    for (int it = F.bid; it < 160 * 2; it += F.G) {
        const int mtile = it >> 1, ntile = it & 1, m0 = mtile * 128, n0 = ntile * 128;
        f32x4 acc[2][4]; float ssq[2] = {0.f, 0.f}; acc_zero(acc);
        gemm_main<false>(F.lds, acc, ssq, APlain{zb, 256}, Wb + WO_GLU, 256, 256, m0, n0, false);
#pragma unroll
        for (int mt = 0; mt < 2; ++mt) { const int row = m0 + 32 * wm + 16 * mt + lr;
#pragma unroll
            for (int nt = 0; nt < 4; ++nt) { const int col = n0 + 64 * wn + 16 * nt + 4 * g; const f32x4 z = up4(*(const u32x2*)(zb + (size_t)row * 256 + col)); f32x4 o;
#pragma unroll
                for (int r = 0; r < 4; ++r) o[r] = z[r] * sigm(acc[mt][nt][r]);
                *(u32x2*)(br + (size_t)row * D + col) = pk4(o); } }
    }
    (void)l; (void)gates; (void)Hb;
}
__device__ __forceinline__ void ph_gate2(int l) {
    const Frame F = mkframe(); unsigned char* const WS = aws(); float* const OUTP = aout(); (void)WS; (void)OUTP;
    const bf16_t* Hb = (const bf16_t*)(WS + WS_H); const bf16_t* Wb = (const bf16_t*)(WS + WS_W);
    bf16_t* gates = (bf16_t*)(WS + WS_G);
    const float* bg = ain(34) + (size_t)l * 4096;
    const int lr = F.lane & 15, g = F.lane >> 4, wm = F.wave >> 1, wn = F.wave & 1;
    for (int it = F.bid; it < 160 * 32; it += F.G) {
        const int mtile = it >> 5, ntile = it & 31, m0 = mtile * 128, n0 = ntile * 128;
        f32x4 acc[2][4]; float ssq[2] = {0.f, 0.f}; acc_zero(acc);
        gemm_main<false>(F.lds, acc, ssq, APlain{Hb, D}, Wb + WO_G, D, D, m0, n0, false);
#pragma unroll
        for (int mt = 0; mt < 2; ++mt) { const int row = m0 + 32 * wm + 16 * mt + lr;
#pragma unroll
            for (int nt = 0; nt < 4; ++nt) { const int col = n0 + 64 * wn + 16 * nt + 4 * g; const f32x4 b = *(const f32x4*)(bg + col); f32x4 o;
#pragma unroll
                for (int r = 0; r < 4; ++r) o[r] = sigm(acc[mt][nt][r] + b[r]);
                *(u32x2*)(gates + (size_t)row * 4096 + col) = pk4(o); } }
    }
}
__device__ __forceinline__ void ph_merge() {
    const Frame F = mkframe(); unsigned char* const WS = aws(); float* const OUTP = aout(); (void)WS; (void)OUTP;
    const bf16_t* br = (const bf16_t*)(WS + WS_BR); const bf16_t* Wb = (const bf16_t*)(WS + WS_W);
    const bf16_t* gates = (const bf16_t*)(WS + WS_G); bf16_t* Hb = (bf16_t*)(WS + WS_H);
    const int lr = F.lane & 15, g = F.lane >> 4, wm = F.wave >> 1, wn = F.wave & 1;
    for (int it = F.bid; it < 160 * 8; it += F.G) {
        const int mtile = it >> 3, ntile = it & 7, m0 = mtile * 128, n0 = ntile * 128;
        f32x4 macc[2][4]; acc_zero(macc);
#pragma unroll 1
        for (int n = 0; n < 4; ++n) {
            f32x4 acc[2][4]; float ssq[2] = {0.f, 0.f}; acc_zero(acc);
            gemm_main<false>(F.lds, acc, ssq, APlain{br + 256 * n, D}, Wb + WO_BR + (size_t)n * 1024 * 256, 256, 256, m0, n0, false);
#pragma unroll
            for (int mt = 0; mt < 2; ++mt) { const int row = m0 + 32 * wm + 16 * mt + lr;
#pragma unroll
                for (int nt = 0; nt < 4; ++nt) { const int col = n0 + 64 * wn + 16 * nt + 4 * g;
                    macc[mt][nt] += up4(*(const u32x2*)(gates + (size_t)row * 4096 + n * 1024 + col)) * acc[mt][nt]; } }
        }
#pragma unroll
        for (int mt = 0; mt < 2; ++mt) { const int row = m0 + 32 * wm + 16 * mt + lr;
#pragma unroll
            for (int nt = 0; nt < 4; ++nt) *(u32x2*)(Hb + (size_t)row * D + n0 + 64 * wn + 16 * nt + 4 * g) = pk4(macc[mt][nt]); }
    }
}

__device__ __forceinline__ void ph_m1(int l) {
    const Frame F = mkframe(); unsigned char* const WS = aws(); float* const OUTP = aout(); (void)WS; (void)OUTP;
    const bf16_t* Wb = (const bf16_t*)(WS + WS_W);
    bf16_t* proj = (bf16_t*)(WS + WS_G + GO_PROJ); bf16_t* Qb = (bf16_t*)(WS + WS_G + GO_QB); bf16_t* Kb = (bf16_t*)(WS + WS_G + GO_KB); bf16_t* Vt = (bf16_t*)(WS + WS_G + GO_VT);
    const bf16_t* rkT = (const bf16_t*)(WS + WS_G + GO_RKT); const bf16_t* rvT = (const bf16_t*)(WS + WS_G + GO_RVT);
    float* retkv = (float*)(WS + WS_G + GO_RETKV); float* s5loc = (float*)(WS + WS_G + GO_S5LOC);
    bf16_t* br = (bf16_t*)(WS + WS_BR);
    const float* rMc = (const float*)(WS + WS_ROPE) + 131072; const float* rMs = rMc + 32768;
    const bf16_t* ctxA = (const bf16_t*)(WS + WS_CTXA) + (size_t)l * 4096 * 128;
    const int lr = F.lane & 15, g = F.lane >> 4, wm = F.wave >> 1, wn = F.wave & 1;

    for (int it = F.bid; it < 160 * 3; it += F.G) {
        const int mtile = it / 3, ntile = it - mtile * 3, m0 = mtile * 128, n0 = ntile * 128;
        f32x4 acc[2][4]; float ssq[2] = {0.f, 0.f}; acc_zero(acc);
        gemm_main<true>(F.lds, acc, ssq, APlain{proj + PC_CQ, PLD}, Wb + WO_UQ, 192, 192, m0, n0, false);
        ssq_finish(ssq);
        const bool samp = m0 >= NPT;
#pragma unroll
        for (int mt = 0; mt < 2; ++mt) {
            const int tok = m0 + 32 * wm + 16 * mt + lr, t = tok_t(tok); const float sc = rsqrtf(ssq[mt] * (1.0f / 192.0f) + EPS) * QSCALE;
#pragma unroll
            for (int nt = 0; nt < 4; ++nt) acc[mt][nt] = acc[mt][nt] * sc;
            if (samp) {
#pragma unroll
                for (int nt = 0; nt < 4; nt += 2) { const int colb = n0 + 64 * wn + 16 * nt;
                    if (colb % 96 == 64) { const f32x4 c = *(const f32x4*)(rMc + t * 16 + 4 * g), s = *(const f32x4*)(rMs + t * 16 + 4 * g);
                        const f32x4 x1 = acc[mt][nt], x2 = acc[mt][nt + 1]; acc[mt][nt] = x1 * c - x2 * s; acc[mt][nt + 1] = x1 * s + x2 * c; } }
            }
#pragma unroll
            for (int nt = 0; nt < 4; ++nt) *(u32x2*)(Qb + (size_t)tok * 384 + n0 + 64 * wn + 16 * nt + 4 * g) = pk4(acc[mt][nt]);
        }
    }
    for (int it = F.bid; it < 192 * 2; it += F.G) {
        const int mtile = it >> 1, ntile = it & 1, n0 = ntile * 128; const bool ctx = mtile >= 160; const int m0 = (ctx ? mtile - 160 : mtile) * 128;
        f32x4 acc[2][4]; float ssq[2] = {0.f, 0.f}; acc_zero(acc);
        if (!ctx) { gemm_main<true>(F.lds, acc, ssq, APlain{proj + PC_CKV, PLD}, Wb + WO_UK, 128, 128, m0, n0, false); ssq_finish(ssq); }
        else gemm_main<false>(F.lds, acc, ssq, APlain{ctxA, 128}, Wb + WO_UKC, 128, 128, m0, n0, false);
        const int head = (n0 + 64 * wn) >> 6;
#pragma unroll
        for (int mt = 0; mt < 2; ++mt) {
            const int row = m0 + 32 * wm + 16 * mt + lr; int keyrow; float sc;
            if (!ctx) { keyrow = tok_keyrow(row); sc = rsqrtf(ssq[mt] * (1.0f / 128.0f) + EPS); } else { keyrow = NPT + (row >> 9) * 2560 + 2048 + (row & 511); sc = 1.0f; }
            bf16_t* kd = Kb + (size_t)keyrow * 384 + head * 96;
#pragma unroll
            for (int nt = 0; nt < 4; ++nt) *(u32x2*)(kd + 16 * nt + 4 * g) = pk4(acc[mt][nt] * sc);
#pragma unroll
            for (int nt = 0; nt < 2; ++nt) {
                u32x2 kr;
                if (!ctx) kr = *(const u32x2*)(proj + (size_t)row * PLD + PC_KR + 16 * nt + 4 * g);
                else kr = pk4(*(const f32x4*)(ain(4) + ((size_t)((row >> 9) * 2 + l) * 512 + (row & 511)) * 160 + 128 + 16 * nt + 4 * g));
                *(u32x2*)(kd + 64 + 16 * nt + 4 * g) = kr;
            }
        }
    }
    for (int it = F.bid; it < 192 * 2; it += F.G) {
        const int mtile = it >> 1, ntile = it & 1, n0 = ntile * 128; const bool ctx = mtile >= 160; const int m0 = (ctx ? mtile - 160 : mtile) * 128;
        f32x4 acc[2][4]; float ssq[2] = {0.f, 0.f}; acc_zero(acc);
        if (!ctx) { gemm_main<true>(F.lds, acc, ssq, APlain{proj + PC_CKV, PLD}, Wb + WO_UV, 128, 128, m0, n0, true); ssq_finish(ssq); }
        else gemm_main<false>(F.lds, acc, ssq, APlain{ctxA, 128}, Wb + WO_UVC, 128, 128, m0, n0, true);
        const int head = (n0 + 64 * wn) >> 6;
#pragma unroll
        for (int mt = 0; mt < 2; ++mt) {
            const int row0 = m0 + 32 * wm + 16 * mt + 4 * g; int s, key0;
            if (!ctx) { s = tok_seq(row0); key0 = tok_t(row0); } else { s = 16 + (row0 >> 9); key0 = 2048 + (row0 & 511); }
            f32x4 sc;
#pragma unroll
            for (int r = 0; r < 4; ++r) { const float q = __shfl(ssq[mt], 4 * g + r); sc[r] = ctx ? 1.0f : rsqrtf(q * (1.0f / 128.0f) + EPS); }
            const int S = seq_keys(s); bf16_t* vb = Vt + (size_t)seq_kbase(s) * 256;
#pragma unroll
            for (int nt = 0; nt < 4; ++nt) *(u32x2*)(vb + (size_t)(head * 64 + 16 * nt + lr) * S + key0) = pk4(acc[mt][nt] * sc);
        }
    }
    for (int it = F.bid; it < 16 * 5 * 2; it += F.G) {
        const int gg = it / 10, r10 = it - gg * 10, m0 = (r10 >> 1) * 128, n0 = (r10 & 1) * 128;
        f32x4 acc[2][4]; float ssq[2] = {0.f, 0.f}; acc_zero(acc);
        gemm_main<false>(F.lds, acc, ssq, AS5U{proj, gg}, Wb + WO_S5WS + (size_t)gg * 256 * 512, 512, 512, m0, n0, false);
#pragma unroll
        for (int mt = 0; mt < 2; ++mt) { const int c = m0 + 32 * wm + 16 * mt + lr;
#pragma unroll
            for (int nt = 0; nt < 4; ++nt) *(f32x4*)(s5loc + ((size_t)c * 16 + gg) * 256 + n0 + 64 * wn + 16 * nt + 4 * g) = acc[mt][nt]; }
    }
    for (int it = F.bid; it < 160 * 4; it += F.G) {
        const int c = it >> 2, h = it & 3, d = F.wave >> 2, dvb = F.wave & 3;
        const float dl = ain(24)[(l * 2 + d) * 4 + h]; const float lg2 = -log1pf(expf(-dl)) * 1.4426950408889634f;
        f32x4 acc[4];
#pragma unroll
        for (int x = 0; x < 4; ++x) acc[x] = (f32x4){0.f, 0.f, 0.f, 0.f};
#pragma unroll
        for (int ks = 0; ks < 4; ++ks) {
            float w[8];
#pragma unroll
            for (int e = 0; e < 8; ++e) { const int j = 32 * ks + 8 * g + e; w[e] = exp2f(lg2 * (float)(d == 0 ? 127 - j : j)); }
            const bf16x8 vf = *(const bf16x8*)(rvT + (((size_t)c * 4 + h) * 64 + 16 * dvb + lr) * 128 + 32 * ks + 8 * g);
#pragma unroll
            for (int x = 0; x < 4; ++x) {
                const u32x4 kr = *(const u32x4*)(rkT + (((size_t)c * 4 + h) * 64 + 16 * x + lr) * 128 + 32 * ks + 8 * g);
                u32x4 ks4; ks4.x = pk2(bflo(kr.x) * w[0], bfhi(kr.x) * w[1]); ks4.y = pk2(bflo(kr.y) * w[2], bfhi(kr.y) * w[3]);
                ks4.z = pk2(bflo(kr.z) * w[4], bfhi(kr.z) * w[5]); ks4.w = pk2(bflo(kr.w) * w[6], bfhi(kr.w) * w[7]);
                acc[x] = __builtin_amdgcn_mfma_f32_16x16x32_bf16(__builtin_bit_cast(bf16x8, ks4), vf, acc[x], 0, 0, 0);
            }
        }
#pragma unroll
        for (int x = 0; x < 4; ++x) *(f32x4*)(retkv + ((((size_t)c * 4 + h) * 2 + d) * 64 + 16 * dvb + lr) * 64 + 16 * x + 4 * g) = acc[x];
    }
    {
        const float* cw = ain(26) + l * 768; const float* cbias = ain(27) + l * 256;
        for (int i = F.gt; i < NTOK * 32; i += F.NGT) {
            const int tok = i >> 5, c0 = (i & 31) * 8, t = tok_t(tok), T = seq_len(tok_seq(tok));
            float z[3][8];
#pragma unroll
            for (int dtk = 0; dtk < 3; ++dtk) {
                const int tt = t + dtk - 1;
                if (tt >= 0 && tt < T) { const u32x4 a = *(const u32x4*)(proj + (size_t)(tok + dtk - 1) * PLD + PC_CC + c0), b = *(const u32x4*)(proj + (size_t)(tok + dtk - 1) * PLD + PC_CX + c0);
                    z[dtk][0] = bflo(a.x) * bflo(b.x); z[dtk][1] = bfhi(a.x) * bfhi(b.x); z[dtk][2] = bflo(a.y) * bflo(b.y); z[dtk][3] = bfhi(a.y) * bfhi(b.y);
                    z[dtk][4] = bflo(a.z) * bflo(b.z); z[dtk][5] = bfhi(a.z) * bfhi(b.z); z[dtk][6] = bflo(a.w) * bflo(b.w); z[dtk][7] = bfhi(a.w) * bfhi(b.w); }
                else {
#pragma unroll
                    for (int e = 0; e < 8; ++e) z[dtk][e] = 0.f; }
            }
            const u32x4 gb = *(const u32x4*)(proj + (size_t)tok * PLD + PC_CB + c0);
            float gv[8] = {bflo(gb.x), bfhi(gb.x), bflo(gb.y), bfhi(gb.y), bflo(gb.z), bfhi(gb.z), bflo(gb.w), bfhi(gb.w)};
            float o[8];
#pragma unroll
            for (int e = 0; e < 8; ++e) o[e] = gv[e] * (cbias[c0 + e] + z[0][e] * cw[c0 + e] + z[1][e] * cw[256 + c0 + e] + z[2][e] * cw[512 + c0 + e]);
            u32x4 ov; ov.x = pk2(o[0], o[1]); ov.y = pk2(o[2], o[3]); ov.z = pk2(o[4], o[5]); ov.w = pk2(o[6], o[7]);
            *(u32x4*)(br + (size_t)tok * D + 512 + c0) = ov;
        }
    }
    for (int tok = F.gw; tok < NPT; tok += F.NGW) {
        const unsigned cv = *(const unsigned*)(proj + (size_t)tok * PLD + PC_CKV + 2 * F.lane);
        const float a = bflo(cv), b = bfhi(cv); const float rstd = rsqrtf(wave_sum(a * a + b * b) * (1.0f / 128.0f) + EPS);
        float* o = OUTP + OUT_CACHE + ((size_t)((tok >> 8) * 2 + l) * 256 + (tok & 255)) * 160;
        o[2 * F.lane] = a * rstd * ain(30)[l * 128 + 2 * F.lane]; o[2 * F.lane + 1] = b * rstd * ain(30)[l * 128 + 2 * F.lane + 1];
        if (F.lane < 32) o[128 + F.lane] = bf1(proj[(size_t)tok * PLD + PC_KR + F.lane]);
    }
}

constexpr int AT_KROW = 208, AT_VROW = 144, AT_KBYTES = 64 * AT_KROW, AT_VBYTES = 64 * AT_VROW;
__device__ __forceinline__ void ph_m2(int l) {
    const Frame F = mkframe(); unsigned char* const WS = aws(); float* const OUTP = aout(); (void)WS; (void)OUTP;
    const bf16_t* Qb = (const bf16_t*)(WS + WS_G + GO_QB); const bf16_t* Kb = (const bf16_t*)(WS + WS_G + GO_KB); const bf16_t* Vt = (const bf16_t*)(WS + WS_G + GO_VT);
    bf16_t* br = (bf16_t*)(WS + WS_BR);
    const int lr = F.lane & 15, g = F.lane >> 4;
    for (int it = F.bid; it < 640; it += F.G) {
        int s, h, qb;
        if (it < 512) { s = 16 + (it >> 6); h = (it >> 4) & 3; qb = it & 15; } else { const int j = it - 512; s = j >> 3; h = (j >> 1) & 3; qb = j & 1; }
        const int S = seq_keys(s), kbase = seq_kbase(s), tok0 = seq_start(s) + qb * 128 + 16 * F.wave, nkt = S >> 6;
        bf16x8 qf[3];
#pragma unroll
        for (int ks = 0; ks < 3; ++ks) qf[ks] = *(const bf16x8*)(Qb + (size_t)(tok0 + lr) * 384 + h * 96 + 32 * ks + 8 * g);
        f32x4 oacc[4];
#pragma unroll
        for (int db = 0; db < 4; ++db) oacc[db] = (f32x4){0.f, 0.f, 0.f, 0.f};
        float m_run = -1e30f, l_run = 0.f;
        const bf16_t* vsrc = Vt + (size_t)kbase * 256 + (size_t)(h * 64) * S;
        for (int kt = 0; kt < nkt; ++kt) {
            __syncthreads();
            for (int q = F.tid; q < 768; q += NTHR) { const int key = q / 12, c12 = q - key * 12;
                *(LAS u32x4*)(F.lds + key * AT_KROW + c12 * 16) = *(const u32x4*)(Kb + (size_t)(kbase + kt * 64 + key) * 384 + h * 96 + c12 * 8); }
            { const int dv = F.tid >> 3, c8 = F.tid & 7;
              *(LAS u32x4*)(F.lds + AT_KBYTES + dv * AT_VROW + c8 * 16) = *(const u32x4*)(vsrc + (size_t)dv * S + kt * 64 + c8 * 8); }
            __syncthreads();
            f32x4 sacc[4];
#pragma unroll
            for (int kb = 0; kb < 4; ++kb) { sacc[kb] = (f32x4){0.f, 0.f, 0.f, 0.f};
#pragma unroll
                for (int ks = 0; ks < 3; ++ks) { const bf16x8 kf = *(const LAS bf16x8*)(F.lds + (16 * kb + lr) * AT_KROW + (4 * ks + g) * 16);
                    sacc[kb] = __builtin_amdgcn_mfma_f32_16x16x32_bf16(kf, qf[ks], sacc[kb], 0, 0, 0); } }
            float mx = -1e30f;
#pragma unroll
            for (int kb = 0; kb < 4; ++kb)
#pragma unroll
                for (int r = 0; r < 4; ++r) mx = fmaxf(mx, sacc[kb][r]);
            mx = fmaxf(mx, __shfl_xor(mx, 16)); mx = fmaxf(mx, __shfl_xor(mx, 32));
            const float m_new = fmaxf(m_run, mx), alpha = exp2f(m_run - m_new); m_run = m_new;
            float ls = 0.f;
#pragma unroll
            for (int kb = 0; kb < 4; ++kb)
#pragma unroll
                for (int r = 0; r < 4; ++r) { const float e = exp2f(sacc[kb][r] - m_new); sacc[kb][r] = e; ls += e; }
            l_run = l_run * alpha + ls;
#pragma unroll
            for (int r = 0; r < 4; ++r) { const float a = __shfl(alpha, 4 * g + r);
#pragma unroll
                for (int db = 0; db < 4; ++db) oacc[db][r] *= a; }
#pragma unroll
            for (int ks2 = 0; ks2 < 2; ++ks2) {
                u32x4 pw; pw.x = pk2(sacc[2 * ks2][0], sacc[2 * ks2][1]); pw.y = pk2(sacc[2 * ks2][2], sacc[2 * ks2][3]);
                pw.z = pk2(sacc[2 * ks2 + 1][0], sacc[2 * ks2 + 1][1]); pw.w = pk2(sacc[2 * ks2 + 1][2], sacc[2 * ks2 + 1][3]);
                const bf16x8 pf = __builtin_bit_cast(bf16x8, pw);
#pragma unroll
                for (int db = 0; db < 4; ++db) {
                    const LAS unsigned char* vp = F.lds + AT_KBYTES + (16 * db + lr) * AT_VROW + (32 * ks2 + 4 * g) * 2;
                    const u32x2 v0 = *(const LAS u32x2*)vp, v1 = *(const LAS u32x2*)(vp + 32);
                    u32x4 vw; vw.x = v0.x; vw.y = v0.y; vw.z = v1.x; vw.w = v1.y;
                    oacc[db] = __builtin_amdgcn_mfma_f32_16x16x32_bf16(pf, __builtin_bit_cast(bf16x8, vw), oacc[db], 0, 0, 0);
                }
            }
        }
        float lt = l_run; lt += __shfl_xor(lt, 16); lt += __shfl_xor(lt, 32);
        const float linv = 1.0f / lt;
#pragma unroll
        for (int r = 0; r < 4; ++r) { const float li = __shfl(linv, 4 * g + r); bf16_t* o = br + (size_t)(tok0 + 4 * g + r) * D + 768 + h * 64 + lr;
#pragma unroll
            for (int db = 0; db < 4; ++db) o[16 * db] = (bf16_t)f2bf(oacc[db][r] * li); }
    }
    __syncthreads();
    {
        const float* pw = (const float*)(WS + WS_S5PW); const float* s5loc = (const float*)(WS + WS_G + GO_S5LOC); bf16_t* s5sin = (bf16_t*)(WS + WS_G + GO_S5SIN);
        for (int i = F.gt; i < 24 * 2048; i += F.NGT) {
            const int q = i & 63, gg = (i >> 6) & 15, d = (i >> 10) & 1, s = i >> 11;
            const size_t ch = ((size_t)(l * 2 + d) * 16 + gg) * 64 + q; const float ar = pw[(ch * 33 + 32) * 2], ai = pw[(ch * 33 + 32) * 2 + 1];
            float sr = 0.f, si = 0.f;
            if (s >= 16) { const float* s0 = ain(2) + ((((size_t)(s - 16) * 2 + l) * 2 + d) * 16 + gg) * 128 + q * 2; sr = s0[0]; si = s0[1]; }
            const int nc = seq_len(s) >> 5, c0 = seq_start(s) >> 5;
            for (int k = 0; k < nc; ++k) {
                const int c = c0 + (d == 0 ? k : nc - 1 - k); const size_t o = ((size_t)c * 16 + gg) * 256 + d * 128 + q;
                s5sin[o] = (bf16_t)f2bf(sr); s5sin[o + 64] = (bf16_t)f2bf(si);
                const float lr_ = s5loc[o], li_ = s5loc[o + 64];
                const float nr = ar * sr - ai * si + lr_, ni = ar * si + ai * sr + li_; sr = nr; si = ni;
            }
            if (s < 16) { float* o = OUTP + OUT_S5 + ((((size_t)s * 2 + l) * 2 + d) * 16 + gg) * 128 + q * 2; o[0] = sr; o[1] = si; }
        }
    }
    {
        const float* retkv = (const float*)(WS + WS_G + GO_RETKV); bf16_t* retsin = (bf16_t*)(WS + WS_G + GO_RETSIN);
        for (int i = F.gt; i < 24 * 8 * 4096; i += F.NGT) {
            const int e = i & 4095, d = (i >> 12) & 1, h = (i >> 13) & 3, s = i >> 15, dv = e >> 6, dk = e & 63;
            const float dl = ain(24)[(l * 2 + d) * 4 + h]; const float g128 = exp2f(-log1pf(expf(-dl)) * 1.4426950408889634f * 128.0f);
            float S = 0.f;
            if (s >= 16) S = ain(3)[(((((size_t)(s - 16) * 2 + l) * 2 + d) * 4 + h) * 64 + dk) * 64 + dv];
            const int nc = seq_len(s) >> 7, c0 = seq_start(s) >> 7;
            for (int k = 0; k < nc; ++k) {
                const int c = c0 + (d == 0 ? k : nc - 1 - k); const size_t o = (((size_t)c * 4 + h) * 2 + d) * 4096 + e;
                retsin[o] = (bf16_t)f2bf(S);
                S = g128 * S + retkv[o];
            }
            if (s < 16) OUTP[OUT_RET + (((((size_t)s * 2 + l) * 2 + d) * 4 + h) * 64 + dk) * 64 + dv] = S;
        }
    }
}

__device__ __forceinline__ void ph_m3(int l) {
    const Frame F = mkframe(); unsigned char* const WS = aws(); float* const OUTP = aout(); (void)WS; (void)OUTP;
    const bf16_t* Wb = (const bf16_t*)(WS + WS_W); const bf16_t* proj = (const bf16_t*)(WS + WS_G + GO_PROJ);
    const bf16_t* s5sin = (const bf16_t*)(WS + WS_G + GO_S5SIN); bf16_t* zb = (bf16_t*)(WS + WS_G + GO_S5LOC);
    const bf16_t* rvT = (const bf16_t*)(WS + WS_G + GO_RVT); const bf16_t* retsin = (const bf16_t*)(WS + WS_G + GO_RETSIN);
    bf16_t* br = (bf16_t*)(WS + WS_BR);
    const int lr = F.lane & 15, g = F.lane >> 4, wm = F.wave >> 1, wn = F.wave & 1;
    for (int it = F.bid; it < 16 * 5 * 4; it += F.G) {
        const int gg = it / 20, r20 = it - gg * 20, m0 = (r20 >> 2) * 128, n0 = (r20 & 3) * 128;
        f32x4 acc[2][4]; float ssq[2] = {0.f, 0.f}; acc_zero(acc);
        gemm_main<false>(F.lds, acc, ssq, AS5U{proj, gg}, Wb + WO_S5T + (size_t)gg * 512 * 512, 512, 512, m0, n0, false);
        gemm_main<false>(F.lds, acc, ssq, APlain{s5sin + gg * 256, 16 * 256}, Wb + WO_S5WO + (size_t)gg * 512 * 256, 256, 256, m0, n0, false);
#pragma unroll
        for (int mt = 0; mt < 2; ++mt) { const int c = m0 + 32 * wm + 16 * mt + lr;
#pragma unroll
            for (int nt = 0; nt < 4; ++nt) { const int n = n0 + 64 * wn + 16 * nt + 4 * g, t = n >> 4, h = n & 15; f32x4 z;
#pragma unroll
                for (int r = 0; r < 4; ++r) z[r] = gelu_t(acc[mt][nt][r]);
                *(u32x2*)(zb + (size_t)(c * 32 + t) * 256 + 16 * gg + h) = pk4(z); } }
    }
    for (int it = F.bid; it < 160 * 4; it += F.G) {
        const int c = it >> 2, h = it & 3, tokq = c * 128 + 16 * F.wave;
        const float lgf = -log1pf(expf(-ain(24)[(l * 2 + 0) * 4 + h])) * 1.4426950408889634f, lgb = -log1pf(expf(-ain(24)[(l * 2 + 1) * 4 + h])) * 1.4426950408889634f;
        bf16x8 qf[2];
#pragma unroll
        for (int ks = 0; ks < 2; ++ks) qf[ks] = *(const bf16x8*)(proj + (size_t)(tokq + lr) * PLD + PC_RQ + h * 64 + 32 * ks + 8 * g);
        f32x4 oacc[4], sfa[4], sba[4];
#pragma unroll
        for (int db = 0; db < 4; ++db) { oacc[db] = (f32x4){0.f, 0.f, 0.f, 0.f}; sfa[db] = oacc[db]; sba[db] = oacc[db]; }
        const int jq = 16 * F.wave + lr;
#pragma unroll 1
        for (int ks2 = 0; ks2 < 4; ++ks2) {
            f32x4 sa[2];
#pragma unroll
            for (int b2 = 0; b2 < 2; ++b2) { const int kb = 2 * ks2 + b2; sa[b2] = (f32x4){0.f, 0.f, 0.f, 0.f};
#pragma unroll
                for (int ks = 0; ks < 2; ++ks) { const bf16x8 kf = *(const bf16x8*)(proj + (size_t)(c * 128 + 16 * kb + lr) * PLD + PC_RK + h * 64 + 32 * ks + 8 * g);
                    sa[b2] = __builtin_amdgcn_mfma_f32_16x16x32_bf16(kf, qf[ks], sa[b2], 0, 0, 0); }
#pragma unroll
                for (int r = 0; r < 4; ++r) { const int ik = 16 * kb + 4 * g + r; const float dec = ik <= jq ? exp2f(lgf * (float)(jq - ik)) : exp2f(lgb * (float)(ik - jq)); sa[b2][r] *= dec; }
            }
            u32x4 pw; pw.x = pk2(sa[0][0], sa[0][1]); pw.y = pk2(sa[0][2], sa[0][3]); pw.z = pk2(sa[1][0], sa[1][1]); pw.w = pk2(sa[1][2], sa[1][3]);
            const bf16x8 pf = __builtin_bit_cast(bf16x8, pw);
#pragma unroll
            for (int db = 0; db < 4; ++db) {
                const bf16_t* vp = rvT + (((size_t)c * 4 + h) * 64 + 16 * db + lr) * 128 + 32 * ks2 + 4 * g;
                const u32x2 v0 = *(const u32x2*)vp, v1 = *(const u32x2*)(vp + 16);
                u32x4 vw; vw.x = v0.x; vw.y = v0.y; vw.z = v1.x; vw.w = v1.y;
                oacc[db] = __builtin_amdgcn_mfma_f32_16x16x32_bf16(pf, __builtin_bit_cast(bf16x8, vw), oacc[db], 0, 0, 0);
            }
        }
#pragma unroll
        for (int ks = 0; ks < 2; ++ks)
#pragma unroll
            for (int db = 0; db < 4; ++db) {
                const bf16x8 s0 = *(const bf16x8*)(retsin + ((((size_t)c * 4 + h) * 2 + 0) * 64 + 16 * db + lr) * 64 + 32 * ks + 8 * g);
                const bf16x8 s1 = *(const bf16x8*)(retsin + ((((size_t)c * 4 + h) * 2 + 1) * 64 + 16 * db + lr) * 64 + 32 * ks + 8 * g);
                sfa[db] = __builtin_amdgcn_mfma_f32_16x16x32_bf16(qf[ks], s0, sfa[db], 0, 0, 0);
                sba[db] = __builtin_amdgcn_mfma_f32_16x16x32_bf16(qf[ks], s1, sba[db], 0, 0, 0);
            }
#pragma unroll
        for (int r = 0; r < 4; ++r) {
            const int jo = 16 * F.wave + 4 * g + r, tok = c * 128 + jo;
            const float qdf = exp2f(lgf * (float)(jo + 1)), qdb = exp2f(lgb * (float)(128 - jo));
            float o[4], sum = 0.f;
#pragma unroll
            for (int db = 0; db < 4; ++db) { o[db] = oacc[db][r] + qdf * sfa[db][r] + qdb * sba[db][r]; sum += o[db]; }
            sum += __shfl_xor(sum, 1); sum += __shfl_xor(sum, 2); sum += __shfl_xor(sum, 4); sum += __shfl_xor(sum, 8);
            const float mu = sum * (1.0f / 64.0f); float var = 0.f;
#pragma unroll
            for (int db = 0; db < 4; ++db) { o[db] -= mu; var += o[db] * o[db]; }
            var += __shfl_xor(var, 1); var += __shfl_xor(var, 2); var += __shfl_xor(var, 4); var += __shfl_xor(var, 8);
            const float rstd = rsqrtf(var * (1.0f / 64.0f) + EPS);
#pragma unroll
            for (int db = 0; db < 4; ++db) { const int ch = h * 64 + 16 * db + lr;
                const float rg = bf1(proj[(size_t)tok * PLD + PC_RG + ch]);
                br[(size_t)tok * D + 256 + ch] = (bf16_t)f2bf(o[db] * rstd * ain(25)[l * 256 + ch] * silu(rg)); }
        }
    }
}

__device__ __forceinline__ void ph_ffn_up8(int f) {
    const Frame F = mkframe(); unsigned char* const WS = aws();
    pg8::Gemm g{(const bf16_t*)(WS + WS_H), (const bf16_t*)(WS + WS_W) + (f ? WO_13B : WO_13A), NTOK, 5632, D};
    pg8::StaticOrder S; S.init(NTOK, 5632, F.G, F.bid);
    EpiUp E{(bf16_t*)(WS + WS_G)};
    pg8::gemm_phase<EpiUp, pg8::StaticOrder, true, true>(F.lds, g, S, E);
}
__device__ __forceinline__ void ph_n1024_8(const bf16_t* A, int K, const bf16_t* Bt, bf16_t* O) {
    const Frame F = mkframe();
    pg8::Gemm g{A, Bt, NTOK, D, K};
    pg8::StaticOrder S; S.init(NTOK, D, F.G, F.bid);
    EpiB16<false> E{O, D, nullptr};
    pg8::gemm_phase<EpiB16<false>, pg8::StaticOrder, true, true>(F.lds, g, S, E);
}
__device__ __forceinline__ void ph_win8() {
    const Frame F = mkframe(); unsigned char* const WS = aws();
    pg8::Gemm g{(const bf16_t*)(WS + WS_H), (const bf16_t*)(WS + WS_W) + WO_IN, NTOK, 2560, D};
    pg8::StaticOrder S; S.init(NTOK, 2560, F.G, F.bid);
    EpiWin E{(bf16_t*)(WS + WS_G + GO_PROJ), (bf16_t*)(WS + WS_G + GO_RKT), (bf16_t*)(WS + WS_G + GO_RVT), (const float*)(WS + WS_ROPE)};
    pg8::gemm_phase<EpiWin, pg8::StaticOrder, true, true>(F.lds, g, S, E);
}
__device__ __forceinline__ void ph_gate8(int l) {
    const Frame F = mkframe(); unsigned char* const WS = aws();
    pg8::Gemm g{(const bf16_t*)(WS + WS_H), (const bf16_t*)(WS + WS_W) + WO_G, NTOK, 4096, D};
    pg8::StaticOrder S; S.init(NTOK, 4096, F.G, F.bid);
    EpiB16<true> E{(bf16_t*)(WS + WS_G), 4096, ain(34) + (size_t)l * 4096};
    pg8::gemm_phase<EpiB16<true>, pg8::StaticOrder, true, true>(F.lds, g, S, E);
}
#ifndef DIAG_OFF
#define DIAG_OFF (WS_H)
#endif
__device__ __forceinline__ void diag_dump() {
    const Frame F = mkframe(); unsigned char* const WS = aws(); float* const OUTP = aout();
    const unsigned* src = (const unsigned*)WS;
    for (size_t i = F.gt; i < 23461888; i += F.NGT) {
        float a = 0.f;
#pragma unroll
        for (int k = 0; k < 4; ++k) { const size_t w = i + (size_t)k * 23461888; if (w >= 262144 && w < (WS_END >> 2)) { const unsigned u = src[w]; a += (float)(u & 0xffffu) * 1e-4f + (float)(u >> 16) * 1e-4f; } }
        OUTP[i] = a;
    }
}
#define W_PTR(off) ((const bf16_t*)(aws() + WS_W) + (off))
#define H_PTR ((bf16_t*)(aws() + WS_H))
#define BR_PTR ((bf16_t*)(aws() + WS_BR))
#define G_PTR ((bf16_t*)(aws() + WS_G))
#define MOD_PTR(l) ((const float*)(aws() + WS_MOD) + (size_t)(l) * 9 * 9216)
__device__ __forceinline__ void grid_bar() {
    XcdBarrier b; b.bar = (unsigned*)(aws() + WS_CTL) + CW_BAR; b.x = xb_xcc_id(); b.st = (volatile LAS unsigned*)((LAS unsigned char*)lds_raw + LDS_BYTES - 64);
    xcd_barrier(b);
}
__global__ void __launch_bounds__(NTHR, 2) hybrid_fwd(Params p) {
    {
        volatile LAS unsigned* misc = (volatile LAS unsigned*)((LAS unsigned char*)lds_raw + LDS_BYTES - 64);
        if (threadIdx.x < 16) misc[threadIdx.x] = 0u;
        __syncthreads();
        (void)xcd_barrier_post((unsigned*)(aws() + WS_CTL) + CW_BAR, misc);
    }
#define GRID_BAR() grid_bar()
    ph_mod(); ph_tables(); ph_wprep(0);
    GRID_BAR();
    ph_s5k();
    ph_rowpass<true, false, true>(nullptr, nullptr, nullptr, 0, 0.f, ain(9), MOD_PTR(0), 0, 1);
    GRID_BAR();
#pragma unroll 1
    for (int l = 0; l < 2; ++l) {
        ph_ffn_up8(0);
        if (l == 0) ph_s5mat(0);
        GRID_BAR();
        ph_n1024_8(G_PTR, FF, W_PTR(WO_2A), BR_PTR);
        GRID_BAR();
        if (l == 0) ph_rowpass<true, true, true>(BR_PTR, ain(10) + (l * 3 + 0) * D, MOD_PTR(l), 2, 0.5f, ain(9) + (l * 3 + 1) * D, MOD_PTR(l), 3, 4);
        else        ph_rowpass<false, true, true>(BR_PTR, ain(10) + (l * 3 + 0) * D, MOD_PTR(l), 2, 0.5f, ain(9) + (l * 3 + 1) * D, MOD_PTR(l), 3, 4);
        GRID_BAR();
        ph_win8();
        GRID_BAR();
        ph_m1(l);
        GRID_BAR();
        ph_m2(l);
        GRID_BAR();
        ph_m3(l);
        GRID_BAR();
        ph_gate(l); ph_gate8(l);
        GRID_BAR();
        ph_merge();
        GRID_BAR();
        ph_n1024_8(H_PTR, D, W_PTR(WO_O), BR_PTR);
        GRID_BAR();
        ph_rowpass<false, true, true>(BR_PTR, ain(10) + (l * 3 + 1) * D, MOD_PTR(l), 5, 1.0f, ain(9) + (l * 3 + 2) * D, MOD_PTR(l), 6, 7);
        GRID_BAR();
        ph_ffn_up8(1);
        GRID_BAR();
        ph_n1024_8(G_PTR, FF, W_PTR(WO_2B), BR_PTR);
        GRID_BAR();
        if (l == 0) {
            ph_rowpass<false, true, true>(BR_PTR, ain(10) + (l * 3 + 2) * D, MOD_PTR(l), 8, 0.5f, ain(9) + 3 * D, MOD_PTR(1), 0, 1);
            ph_wprep(1); ph_s5mat(1);
            GRID_BAR();
        } else {
            ph_rowpass<false, true, false>(BR_PTR, ain(10) + (l * 3 + 2) * D, MOD_PTR(l), 8, 0.5f, nullptr, nullptr, 0, 0);
        }
    }
}

extern "C" void kernel_launch(void* const* d_in, const int* in_sizes, int n_in, void* d_out, int out_size, void* d_ws, size_t ws_size, hipStream_t stream) {
    static int grid = 0;
    if (grid == 0) {
        if (n_in != 36 || out_size != 23461888 || ws_size < WS_END) { fprintf(stderr, "kernel_launch: unexpected problem shape (n_in %d, out %d, ws %zu; need ws >= %zu)\n", n_in, out_size, ws_size, (size_t)WS_END); grid = -1; return; }
        int dev = 0, cus = 0, per_cu = 0;
        if (hipGetDevice(&dev) != hipSuccess || hipDeviceGetAttribute(&cus, hipDeviceAttributeMultiprocessorCount, dev) != hipSuccess) { grid = -1; return; }
        if (hipFuncSetAttribute((const void*)hybrid_fwd, hipFuncAttributeMaxDynamicSharedMemorySize, LDS_BYTES) != hipSuccess) { fprintf(stderr, "kernel_launch: hipFuncSetAttribute failed\n"); grid = -1; return; }
        if (hipOccupancyMaxActiveBlocksPerMultiprocessor(&per_cu, (const void*)hybrid_fwd, NTHR, LDS_BYTES) != hipSuccess || per_cu < 1)
            fprintf(stderr, "kernel_launch: occupancy query reports %d blocks/CU\n", per_cu);
        (void)hipGetLastError();
        grid = cus;
    }
    if (grid < 0) return;
    (void)hipMemsetAsync((char*)d_ws + WS_CTL, 0, 65536, stream);
    Params prm{};
    for (int i = 0; i < 36; ++i) prm.in[i] = (const float*)d_in[i];
    prm.out = (float*)d_out; prm.ws = (unsigned char*)d_ws;
    hipLaunchKernelGGL(hybrid_fwd, dim3(grid), dim3(NTHR), LDS_BYTES, stream, prm);
}
```
